# Optimizing an MI355X kernel written in HIP

```python
import math
import jax, jax.numpy as jnp
from jax import lax
import numpy as np

D_MODEL = 1024
BATCH = 8
SEQ = 8192
DEPTH = 1

HEAD_DIM = 64
NSA_HEADS = D_MODEL // 2 // HEAD_DIM
NSA_KV_GROUPS = 2
CMP_BLOCK = 32
CMP_STRIDE = 16
CMP_HIDDEN = 256
SEL_BLOCK = 64
SEL_TOPN = 16
NSA_WINDOW = 512
SWA_HEADS = D_MODEL // 2 // HEAD_DIM
SWA_KV_HEADS = 2
SWA_WINDOW = 128
REL_BUCKETS = 32
REL_MAX_DIST = 128
MEM_LEN = 256
XATTN_HEADS = 4
XATTN_HEAD_DIM = D_MODEL // XATTN_HEADS
D_FF = ((8 * D_MODEL // 3 + 127) // 128) * 128
NSA_WIDTH = NSA_HEADS * HEAD_DIM
NSA_KV_WIDTH = NSA_KV_GROUPS * HEAD_DIM
SWA_WIDTH = SWA_HEADS * HEAD_DIM
SWA_KV_WIDTH = SWA_KV_HEADS * HEAD_DIM
IN_WIDTH = NSA_WIDTH + 6 * NSA_KV_WIDTH + 3 * NSA_HEADS + SWA_WIDTH + 2 * SWA_KV_WIDTH + 2 * D_MODEL
Q_BLOCK = 128
EPS = 1e-6
NEG_INF = -1e30
FORCE = 1e4

kernel_name = 'hybrid_nsa_swa_sink_macaron_layer'


def rms_norm(x, g):
    xf = x.astype(jnp.float32)
    y = xf * lax.rsqrt(jnp.mean(xf * xf, axis=-1, keepdims=True) + EPS)
    return (y * g.astype(jnp.float32)).astype(x.dtype)


def swiglu(h, w_gate, w_up, w_down):
    return (jax.nn.silu(h @ w_gate) * (h @ w_up)) @ w_down


def rel_bucket(dist):
    dist = jnp.maximum(dist, 0)
    max_exact = REL_BUCKETS // 2
    d = jnp.maximum(dist, 1).astype(jnp.float32)
    large = max_exact + (jnp.log(d / max_exact) / math.log(REL_MAX_DIST / max_exact)
                         * (REL_BUCKETS - max_exact)).astype(jnp.int32)
    large = jnp.minimum(large, REL_BUCKETS - 1)
    return jnp.where(dist < max_exact, dist, large)


def masked_softmax(logits, mask):
    logits = jnp.where(mask, logits.astype(jnp.float32), NEG_INF)
    p = jax.nn.softmax(logits, axis=-1)
    return jnp.where(mask, p, 0.0)


def sink_softmax(logits, mask, sinks):
    logits = jnp.where(mask, logits.astype(jnp.float32), NEG_INF)
    sink = jnp.broadcast_to(sinks.astype(jnp.float32), logits.shape[:-1] + (1,))
    p = jax.nn.softmax(jnp.concatenate([logits, sink], axis=-1), axis=-1)[..., :-1]
    return jnp.where(mask, p, 0.0)


def token_mixing(h, w_in, cmp_pe_k, cmp_w1_k, cmp_w2_k, cmp_pe_v, cmp_w1_v, cmp_w2_v,
                 attn_sinks, rel_bias, w_up_a, w_up_b, w_out):
    B, S, _ = h.shape
    G, HPG = NSA_KV_GROUPS, NSA_HEADS // NSA_KV_GROUPS
    KB, HPB = SWA_KV_HEADS, SWA_HEADS // SWA_KV_HEADS
    sizes = [NSA_WIDTH] + [NSA_KV_WIDTH] * 6 + [3 * NSA_HEADS, SWA_WIDTH, SWA_KV_WIDTH, SWA_KV_WIDTH,
                                               D_MODEL, D_MODEL]
    splits = [int(s) for s in np.cumsum(sizes)[:-1]]
    proj = h @ w_in
    (q_a, k_c, v_c, k_s, v_s, k_w, v_w, g_nsa, q_b, k_b, v_b, gate_a, gate_b) = jnp.split(proj, splits, axis=-1)
    scale = HEAD_DIM ** -0.5
    q_a = q_a.reshape(B, S, G, HPG, HEAD_DIM) * scale
    k_c, v_c, k_s, v_s, k_w, v_w = [a.reshape(B, S, G, HEAD_DIM) for a in (k_c, v_c, k_s, v_s, k_w, v_w)]
    g_nsa = jax.nn.sigmoid(g_nsa).reshape(B, S, 3, G, HPG)
    q_b = q_b.reshape(B, S, KB, HPB, HEAD_DIM) * scale
    k_b = k_b.reshape(B, S, KB, HEAD_DIM)
    v_b = v_b.reshape(B, S, KB, HEAD_DIM)

    n_cmp = (S - CMP_BLOCK) // CMP_STRIDE + 1
    cmp_start = jnp.arange(n_cmp) * CMP_STRIDE
    cmp_end = cmp_start + CMP_BLOCK - 1
    tok = cmp_start[:, None] + jnp.arange(CMP_BLOCK)[None, :]

    def compress(a, pe, w1, w2):
        blocks = a[:, tok] + pe[None, None, :, None, :]
        flat = blocks.transpose(0, 1, 3, 2, 4).reshape(B, n_cmp, G, CMP_BLOCK * HEAD_DIM)
        return jax.nn.gelu(flat @ w1) @ w2

    kc = compress(k_c, cmp_pe_k, cmp_w1_k, cmp_w2_k)
    vc = compress(v_c, cmp_pe_v, cmp_w1_v, cmp_w2_v)

    n_sel = S // SEL_BLOCK
    top_n = min(SEL_TOPN, n_sel)
    sel_start = jnp.arange(n_sel) * SEL_BLOCK
    ov = (jnp.minimum(cmp_start[:, None] + CMP_BLOCK, sel_start[None, :] + SEL_BLOCK)
          - jnp.maximum(cmp_start[:, None], sel_start[None, :]))
    overlap = (jnp.maximum(ov, 0) / CMP_BLOCK).astype(jnp.float32)
    ks_blk = k_s.reshape(B, n_sel, SEL_BLOCK, G, HEAD_DIM)
    vs_blk = v_s.reshape(B, n_sel, SEL_BLOCK, G, HEAD_DIM)

    k_w_pad = jnp.pad(k_w, ((0, 0), (NSA_WINDOW, 0), (0, 0), (0, 0)))
    v_w_pad = jnp.pad(v_w, ((0, 0), (NSA_WINDOW, 0), (0, 0), (0, 0)))
    k_b_pad = jnp.pad(k_b, ((0, 0), (SWA_WINDOW, 0), (0, 0), (0, 0)))
    v_b_pad = jnp.pad(v_b, ((0, 0), (SWA_WINDOW, 0), (0, 0), (0, 0)))

    bias_a = rel_bias[:, :NSA_HEADS].reshape(REL_BUCKETS, G, HPG)
    bias_b = rel_bias[:, NSA_HEADS:].reshape(REL_BUCKETS, KB, HPB)
    sinks = attn_sinks.reshape(KB, HPB, 1)
    b_ix = jnp.arange(B)[:, None, None, None]
    g_ix = jnp.arange(G)[None, None, :, None]
    blk_j = jnp.arange(n_sel)

    def query_block(c):
        s0 = c * Q_BLOCK
        t = s0 + jnp.arange(Q_BLOCK)
        qa = lax.dynamic_slice_in_dim(q_a, s0, Q_BLOCK, axis=1)

        dist_c = t[:, None] - cmp_end[None, :]
        s_c = jnp.einsum('bqghd,bngd->bqghn', qa, kc) + bias_a[rel_bucket(dist_c)].transpose(0, 2, 3, 1)
        p_c = masked_softmax(s_c, (dist_c >= 0)[:, None, None, :])
        o_c = jnp.einsum('bqghn,bngd->bqghd', p_c.astype(vc.dtype), vc)

        imp = jnp.einsum('bqghn,nj->bqgj', p_c, overlap)
        cur = (t // SEL_BLOCK)[:, None]
        forced = (blk_j[None] == 0) | (blk_j[None] == cur) | (blk_j[None] == cur - 1)
        causal = blk_j[None] * SEL_BLOCK <= t[:, None]
        imp = jnp.where(forced[:, None, :], FORCE, jnp.where(causal[:, None, :], imp, -FORCE))
        _, idx = lax.top_k(imp, top_n)
        ks = ks_blk[b_ix, idx, :, g_ix, :].reshape(B, Q_BLOCK, G, top_n * SEL_BLOCK, HEAD_DIM)
        vs = vs_blk[b_ix, idx, :, g_ix, :].reshape(B, Q_BLOCK, G, top_n * SEL_BLOCK, HEAD_DIM)
        kpos = (idx[..., None] * SEL_BLOCK + jnp.arange(SEL_BLOCK)).reshape(B, Q_BLOCK, G, top_n * SEL_BLOCK)
        dist_s = t[None, :, None, None] - kpos
        s_s = (jnp.einsum('bqghd,bqgkd->bqghk', qa, ks)
               + jnp.moveaxis(bias_a[rel_bucket(dist_s), g_ix], -1, 3))
        p_s = masked_softmax(s_s, (dist_s >= 0)[:, :, :, None, :])
        o_s = jnp.einsum('bqghk,bqgkd->bqghd', p_s.astype(vs.dtype), vs)

        kw = lax.dynamic_slice_in_dim(k_w_pad, s0, NSA_WINDOW + Q_BLOCK, axis=1)
        vw = lax.dynamic_slice_in_dim(v_w_pad, s0, NSA_WINDOW + Q_BLOCK, axis=1)
        kwpos = s0 - NSA_WINDOW + jnp.arange(NSA_WINDOW + Q_BLOCK)
        dist_w = t[:, None] - kwpos[None, :]
        mask_w = (dist_w >= 0) & (dist_w < NSA_WINDOW) & (kwpos[None, :] >= 0)
        s_w = jnp.einsum('bqghd,bkgd->bqghk', qa, kw) + bias_a[rel_bucket(dist_w)].transpose(0, 2, 3, 1)
        p_w = masked_softmax(s_w, mask_w[:, None, None, :])
        o_w = jnp.einsum('bqghk,bkgd->bqghd', p_w.astype(vw.dtype), vw)

        g = lax.dynamic_slice_in_dim(g_nsa, s0, Q_BLOCK, axis=1)
        o_a = g[:, :, 0, :, :, None] * o_c + g[:, :, 1, :, :, None] * o_s + g[:, :, 2, :, :, None] * o_w

        qb = lax.dynamic_slice_in_dim(q_b, s0, Q_BLOCK, axis=1)
        kb = lax.dynamic_slice_in_dim(k_b_pad, s0, SWA_WINDOW + Q_BLOCK, axis=1)
        vb = lax.dynamic_slice_in_dim(v_b_pad, s0, SWA_WINDOW + Q_BLOCK, axis=1)
        kbpos = s0 - SWA_WINDOW + jnp.arange(SWA_WINDOW + Q_BLOCK)
        dist_b = t[:, None] - kbpos[None, :]
        mask_b = (dist_b >= 0) & (dist_b < SWA_WINDOW) & (kbpos[None, :] >= 0)
        s_b = jnp.einsum('bqnhd,bjnd->bqnhj', qb, kb) + bias_b[rel_bucket(dist_b)].transpose(0, 2, 3, 1)
        p_b = sink_softmax(s_b, mask_b[:, None, None, :], sinks)
        o_b = jnp.einsum('bqnhj,bjnd->bqnhd', p_b.astype(vb.dtype), vb)
        return o_a.reshape(B, Q_BLOCK, NSA_WIDTH), o_b.reshape(B, Q_BLOCK, SWA_WIDTH)

    o_a, o_b = lax.map(query_block, jnp.arange(S // Q_BLOCK))
    o_a = o_a.transpose(1, 0, 2, 3).reshape(B, S, NSA_WIDTH)
    o_b = o_b.transpose(1, 0, 2, 3).reshape(B, S, SWA_WIDTH)
    merged = jax.nn.sigmoid(gate_a) * (o_a @ w_up_a) + jax.nn.sigmoid(gate_b) * (o_b @ w_up_b)
    return merged @ w_out


def memory_xattn(h, m, w_xq, w_xkv, w_xo):
    B, S, _ = h.shape
    q = (h @ w_xq).reshape(B, S, XATTN_HEADS, XATTN_HEAD_DIM) * XATTN_HEAD_DIM ** -0.5
    k, v = jnp.split(m @ w_xkv, 2, axis=-1)
    k = k.reshape(B, -1, XATTN_HEADS, XATTN_HEAD_DIM)
    v = v.reshape(B, -1, XATTN_HEADS, XATTN_HEAD_DIM)
    p = jax.nn.softmax(jnp.einsum('bshd,bmhd->bhsm', q, k).astype(jnp.float32), axis=-1)
    o = jnp.einsum('bhsm,bmhd->bshd', p.astype(v.dtype), v)
    return o.reshape(B, S, D_MODEL) @ w_xo


def setup_inputs(seed: int = 0) -> dict:
    key = jax.random.key(seed)
    keys = iter(jax.random.split(key, 40))

    def w(shape, fan_in):
        return jax.random.normal(next(keys), shape, jnp.float32) * fan_in ** -0.5

    def gain(n=D_MODEL):
        return 1.0 + 0.01 * jax.random.normal(next(keys), (DEPTH, n), jnp.float32)

    L = DEPTH
    return {
        'x': jax.random.normal(next(keys), (BATCH, SEQ, D_MODEL), jnp.float32),
        'mem': jax.random.normal(next(keys), (BATCH, MEM_LEN, D_MODEL), jnp.float32),
        'norm_ffn1': gain(),
        'w1_gate': w((L, D_MODEL, D_FF), D_MODEL),
        'w1_up': w((L, D_MODEL, D_FF), D_MODEL),
        'w1_down': w((L, D_FF, D_MODEL), D_FF),
        'norm_mix': gain(),
        'w_in': w((L, D_MODEL, IN_WIDTH), D_MODEL),
        'cmp_pe_k': 0.1 * jax.random.normal(next(keys), (L, CMP_BLOCK, HEAD_DIM), jnp.float32),
        'cmp_w1_k': w((L, CMP_BLOCK * HEAD_DIM, CMP_HIDDEN), CMP_BLOCK * HEAD_DIM),
        'cmp_w2_k': w((L, CMP_HIDDEN, HEAD_DIM), CMP_HIDDEN),
        'cmp_pe_v': 0.1 * jax.random.normal(next(keys), (L, CMP_BLOCK, HEAD_DIM), jnp.float32),
        'cmp_w1_v': w((L, CMP_BLOCK * HEAD_DIM, CMP_HIDDEN), CMP_BLOCK * HEAD_DIM),
        'cmp_w2_v': w((L, CMP_HIDDEN, HEAD_DIM), CMP_HIDDEN),
        'attn_sinks': jax.random.normal(next(keys), (L, SWA_HEADS), jnp.float32),
        'rel_bias': 0.5 * jax.random.normal(next(keys), (REL_BUCKETS, NSA_HEADS + SWA_HEADS), jnp.float32),
        'w_up_a': w((L, NSA_WIDTH, D_MODEL), NSA_WIDTH),
        'w_up_b': w((L, SWA_WIDTH, D_MODEL), SWA_WIDTH),
        'w_out': w((L, D_MODEL, D_MODEL), D_MODEL),
        'norm_xattn': gain(),
        'norm_mem': gain(),
        'w_xq': w((L, D_MODEL, D_MODEL), D_MODEL),
        'w_xkv': w((L, D_MODEL, 2 * D_MODEL), D_MODEL),
        'w_xo': w((L, D_MODEL, D_MODEL), D_MODEL),
        'norm_ffn2': gain(),
        'w2_gate': w((L, D_MODEL, D_FF), D_MODEL),
        'w2_up': w((L, D_MODEL, D_FF), D_MODEL),
        'w2_down': w((L, D_FF, D_MODEL), D_FF),
        'norm_final': 1.0 + 0.01 * jax.random.normal(next(keys), (D_MODEL,), jnp.float32),
    }


def reference(x, mem, norm_ffn1, w1_gate, w1_up, w1_down, norm_mix, w_in,
              cmp_pe_k, cmp_w1_k, cmp_w2_k, cmp_pe_v, cmp_w1_v, cmp_w2_v,
              attn_sinks, rel_bias, w_up_a, w_up_b, w_out,
              norm_xattn, norm_mem, w_xq, w_xkv, w_xo,
              norm_ffn2, w2_gate, w2_up, w2_down, norm_final):
    for l in range(DEPTH):
        x = x + 0.5 * swiglu(rms_norm(x, norm_ffn1[l]), w1_gate[l], w1_up[l], w1_down[l])
        x = x + token_mixing(rms_norm(x, norm_mix[l]), w_in[l],
                             cmp_pe_k[l], cmp_w1_k[l], cmp_w2_k[l], cmp_pe_v[l], cmp_w1_v[l], cmp_w2_v[l],
                             attn_sinks[l], rel_bias, w_up_a[l], w_up_b[l], w_out[l])
        x = x + memory_xattn(rms_norm(x, norm_xattn[l]), rms_norm(mem, norm_mem[l]), w_xq[l], w_xkv[l], w_xo[l])
        x = x + 0.5 * swiglu(rms_norm(x, norm_ffn2[l]), w2_gate[l], w2_up[l], w2_down[l])
    return rms_norm(x, norm_final)
```

```cpp
#include <hip/hip_runtime.h>
#include <hip/hip_cooperative_groups.h>
#include <cstdio>
#include <cstdint>
namespace cg = cooperative_groups;

namespace pg8 {
#define PG8_LAS __attribute__((address_space(3)))
typedef unsigned short bf16_t;
typedef short bf16x8 __attribute__((ext_vector_type(8)));
typedef float f32x4 __attribute__((ext_vector_type(4)));
typedef unsigned u32x4 __attribute__((ext_vector_type(4)));
typedef unsigned u32x2 __attribute__((ext_vector_type(2)));
constexpr int BM = 256, BK = 64, HALF = 128, HTB = HALF * BK * 2, STAGE_BYTES = 8 * HTB, NXCD = 8, WGM = 8;

__host__ __device__ __forceinline__ int lds_byte(int r, int c) { const int st = (r >> 4) * 2 + (c >> 5), rr = r & 15, cc = c & 31, ob = rr * 64 + cc * 2; return st * 1024 + (ob ^ (((ob >> 9) & 1) << 5)); }
__host__ __device__ __forceinline__ void stage_rc(int b, int& R, int& C) { const int st = b / 1024, sb = b % 1024, swz = sb ^ (((sb >> 9) & 1) << 5); R = (st >> 1) * 16 + swz / 64; C = (st & 1) * 32 + (swz % 64) / 2; }
__host__ __device__ __forceinline__ int perm32(int rho) { const int n = rho >> 4, i = rho & 15; return 8 * (i >> 2) + 4 * n + (i & 3); }

struct Unit { int pm, pn; long aoff, boff; };
struct Gemm { const bf16_t* A; const bf16_t* Bt; int lda, ldb, K; int ksa = 128; };

struct StaticOrder {
    int nM, nN, nwg, G, c, lda, ldb;
    __device__ void init(int M, int N, int lda_, int ldb_, int G_, int c_) { nM = M / BM; nN = N / BM; nwg = nM * nN; G = G_; c = c_; lda = lda_; ldb = ldb_; }
    __device__ bool next(int i, Unit& u) const {
        const long L = (long)i * G + c; if (L >= nwg) return false;
        int wgid = (int)L; { const int q = nwg / NXCD, r = nwg % NXCD, xcd = wgid % NXCD, off = wgid / NXCD; wgid = (xcd < r ? xcd * (q + 1) : r * (q + 1) + (xcd - r) * q) + off; }
        const int nig = WGM * nN, gid = wgid / nig, fm = gid * WGM, gsz = (nM - fm) < WGM ? (nM - fm) : WGM;
        u.pm = fm + ((wgid % nig) % gsz); u.pn = (wgid % nig) / gsz;
        u.aoff = (long)u.pm * BM * lda; u.boff = (long)u.pn * BM * ldb; return true;
    }
};

__device__ __forceinline__ unsigned cvt_pk_bf16(float lo, float hi) { unsigned r; asm volatile("v_cvt_pk_bf16_f32 %0, %1, %2" : "=v"(r) : "v"(lo), "v"(hi)); return r; }
__device__ __forceinline__ float bf2f(unsigned short v) { return __uint_as_float(((unsigned)v) << 16); }
__device__ __forceinline__ float fsigmoid(float x) { return __builtin_amdgcn_rcpf(1.0f + __builtin_amdgcn_exp2f(-1.4426950408889634f * x)); }


__device__ __forceinline__ float row_rstd(const float* ssp, int row) {
    const f32x4* p4 = (const f32x4*)(ssp + (size_t)row * 16); const f32x4 a = p4[0], b = p4[1], c = p4[2], d = p4[3];
    const float t = (((a[0] + a[1]) + (a[2] + a[3])) + ((b[0] + b[1]) + (b[2] + b[3]))) + (((c[0] + c[1]) + (c[2] + c[3])) + ((d[0] + d[1]) + (d[2] + d[3])));
    return __builtin_amdgcn_rsqf(t * (1.f / 1024.f) + 1e-6f);
}
struct EpiSwiglu {
    static constexpr bool PERM = true;
    bf16_t* H; int ldh; const float* ss;
    __device__ __forceinline__ void operator()(const f32x4 (&acc)[2][2][4][2], const Unit& u, int wr, int wc, int fr, int fq) const {
        const int row0 = u.pm * BM + wr * 64 + fr, col0 = u.pn * 128 + wc * 32 + 8 * fq;
#pragma unroll
        for (int ai = 0; ai < 2; ++ai)
#pragma unroll
            for (int m = 0; m < 4; ++m) {
                bf16_t* p = H + (size_t)(row0 + ai * HALF + m * 16) * ldh + col0;
                const float rs = ss ? row_rstd(ss, row0 + ai * HALF + m * 16) : 1.0f;
                float h[8];
#pragma unroll
                for (int n = 0; n < 2; ++n)
#pragma unroll
                    for (int e = 0; e < 4; ++e) { const float gv = acc[ai][0][m][n][e] * rs, uv = acc[ai][1][m][n][e] * rs; h[n * 4 + e] = gv * fsigmoid(gv) * uv; }
                u32x4 w; w.x = cvt_pk_bf16(h[0], h[1]); w.y = cvt_pk_bf16(h[2], h[3]); w.z = cvt_pk_bf16(h[4], h[5]); w.w = cvt_pk_bf16(h[6], h[7]);
                *(u32x4*)p = w;
            }
    }
};
struct EpiResid {
    static constexpr bool PERM = true;
    const float* basef; bf16_t* xs; float* ss; float alpha;
    __device__ __forceinline__ void operator()(const f32x4 (&acc)[2][2][4][2], const Unit& u, int wr, int wc, int fr, int fq) const {
        const int col0 = u.pn * BM + wc * 32 + 8 * fq;
#pragma unroll
        for (int ai = 0; ai < 2; ++ai)
#pragma unroll
            for (int m = 0; m < 4; ++m) {
                const int row = u.pm * BM + ai * HALF + wr * 64 + m * 16 + fr;
                const size_t off = (size_t)row * 1024 + col0; float sq = 0.f;
#pragma unroll
                for (int bj = 0; bj < 2; ++bj) {
                    float bv[8];
                    if (basef) { const f32x4 b0 = *(const f32x4*)(basef + off + bj * HALF), b1 = *(const f32x4*)(basef + off + bj * HALF + 4);
                        bv[0] = b0[0]; bv[1] = b0[1]; bv[2] = b0[2]; bv[3] = b0[3]; bv[4] = b1[0]; bv[5] = b1[1]; bv[6] = b1[2]; bv[7] = b1[3]; }
                    else { const u32x4 gw = *(const u32x4*)(xs + off + bj * HALF);
                        bv[0] = __uint_as_float(gw.x << 16); bv[1] = __uint_as_float(gw.x & 0xffff0000u); bv[2] = __uint_as_float(gw.y << 16); bv[3] = __uint_as_float(gw.y & 0xffff0000u);
                        bv[4] = __uint_as_float(gw.z << 16); bv[5] = __uint_as_float(gw.z & 0xffff0000u); bv[6] = __uint_as_float(gw.w << 16); bv[7] = __uint_as_float(gw.w & 0xffff0000u); }
                    float y[8];
#pragma unroll
                    for (int e = 0; e < 4; ++e) { y[e] = bv[e] + alpha * acc[ai][bj][m][0][e]; y[4 + e] = bv[4 + e] + alpha * acc[ai][bj][m][1][e]; }
                    u32x4 w; w.x = cvt_pk_bf16(y[0], y[1]); w.y = cvt_pk_bf16(y[2], y[3]); w.z = cvt_pk_bf16(y[4], y[5]); w.w = cvt_pk_bf16(y[6], y[7]);
                    *(u32x4*)(xs + off + bj * HALF) = w;
                    if (ss) sq += ((y[0] * y[0] + y[1] * y[1]) + (y[2] * y[2] + y[3] * y[3])) + ((y[4] * y[4] + y[5] * y[5]) + (y[6] * y[6] + y[7] * y[7]));
                }
                if (ss) { sq += __shfl_xor(sq, 16); sq += __shfl_xor(sq, 32); if (fq == 0) ss[(size_t)row * 16 + u.pn * 4 + wc] = sq; }
            }
    }
};
struct EpiBf16 {
    static constexpr bool PERM = true;
    bf16_t* O0; int ld0; int split_pn; bf16_t* O1; int ld1; int act0, act1; const float* rowscale; const float* ss; const float* cbias;
    __device__ __forceinline__ void operator()(const f32x4 (&acc)[2][2][4][2], const Unit& u, int wr, int wc, int fr, int fq) const {
        bf16_t* O = O0; int ld = ld0, colt = u.pn * BM, act = act0;
        if (u.pn >= split_pn) { O = O1; ld = ld1; colt = (u.pn - split_pn) * BM; act = act1; }
        const int row0 = u.pm * BM + wr * 64 + fr, col0 = colt + wc * 32 + 8 * fq;
#pragma unroll
        for (int ai = 0; ai < 2; ++ai)
#pragma unroll
            for (int m = 0; m < 4; ++m) {
                const int row = row0 + ai * HALF + m * 16;
                float rs = 1.0f; if (rowscale) { const f32x4 lp = *(const f32x4*)(rowscale + ((size_t)row * 4 + u.pn) * 4); rs = __builtin_amdgcn_rcpf((lp[0] + lp[1]) + (lp[2] + lp[3])); }
                if (ss) rs = row_rstd(ss, row);
                bf16_t* rowp = O + (size_t)row * ld + col0;
#pragma unroll
                for (int bj = 0; bj < 2; ++bj) {
                    float h[8];
#pragma unroll
                    for (int n = 0; n < 2; ++n)
#pragma unroll
                        for (int e = 0; e < 4; ++e) {
                            float x = acc[ai][bj][m][n][e] * rs;
                            if (cbias) x += cbias[(u.pm >> 5) * 256 + (col0 - colt) + bj * HALF + n * 4 + e];
                            if (act == 1) x = fsigmoid(x);
                            else if (act == 2) { const float z = 1.5957691216057308f * (x + 0.044715f * x * x * x); x = x * fsigmoid(z); }
                            h[n * 4 + e] = x;
                        }
                    u32x4 w; w.x = cvt_pk_bf16(h[0], h[1]); w.y = cvt_pk_bf16(h[2], h[3]); w.z = cvt_pk_bf16(h[4], h[5]); w.w = cvt_pk_bf16(h[6], h[7]);
                    *(u32x4*)(rowp + bj * HALF) = w;
                }
            }
    }
};
struct EpiCmp2 {
    static constexpr bool PERM = true;
    bf16_t* KC; bf16_t* VCT;
    __device__ __forceinline__ void operator()(const f32x4 (&acc)[2][2][4][2], const Unit& u, int wr, int wc, int fr, int fq) const {
        if (wc >= 2) return;
        const int col0 = wc * 32 + 8 * fq;
#pragma unroll
        for (int ai = 0; ai < 2; ++ai)
#pragma unroll
            for (int m = 0; m < 4; ++m) {
                const int row = u.pm * BM + ai * HALF + wr * 64 + m * 16 + fr;
                if (u.pm < 32) {
                    u32x4 w; w.x = cvt_pk_bf16(acc[ai][0][m][0][0], acc[ai][0][m][0][1]); w.y = cvt_pk_bf16(acc[ai][0][m][0][2], acc[ai][0][m][0][3]);
                    w.z = cvt_pk_bf16(acc[ai][0][m][1][0], acc[ai][0][m][1][1]); w.w = cvt_pk_bf16(acc[ai][0][m][1][2], acc[ai][0][m][1][3]);
                    *(u32x4*)(KC + (size_t)row * 64 + col0) = w;
                } else {
                    const int r2 = row - 8192, bg = r2 >> 9, n = r2 & 511;
#pragma unroll
                    for (int nn = 0; nn < 2; ++nn)
#pragma unroll
                        for (int e = 0; e < 4; ++e) VCT[(size_t)(bg * 64 + col0 + nn * 4 + e) * 512 + n] = (bf16_t)(cvt_pk_bf16(acc[ai][0][m][nn][e], 0.f) & 0xffffu);
                }
            }
    }
};
__device__ __forceinline__ void unpack8(float (&gv)[8], const u32x4& gw) {
    gv[0] = __uint_as_float(gw.x << 16); gv[1] = __uint_as_float(gw.x & 0xffff0000u); gv[2] = __uint_as_float(gw.y << 16); gv[3] = __uint_as_float(gw.y & 0xffff0000u);
    gv[4] = __uint_as_float(gw.z << 16); gv[5] = __uint_as_float(gw.z & 0xffff0000u); gv[6] = __uint_as_float(gw.w << 16); gv[7] = __uint_as_float(gw.w & 0xffff0000u);
}
struct EpiGate {
    static constexpr bool PERM = true, HOOK = true;
    const bf16_t* gate; int ldg; bf16_t* MO;
    __device__ __forceinline__ void hook(f32x4 (&acc)[2][2][4][2], const Unit& u, int wr, int wc, int fr, int fq) const {
        int row0 = u.pm * BM + wr * 64 + fr, col0 = u.pn * BM + wc * 32 + 8 * fq;
        asm volatile("" : "+v"(row0), "+v"(col0));
#pragma unroll
        for (int ai = 0; ai < 2; ++ai)
#pragma unroll
            for (int m = 0; m < 4; ++m)
#pragma unroll
                for (int bj = 0; bj < 2; ++bj) {
                    const unsigned goff = ((unsigned)(row0 + ai * HALF + m * 16) * (unsigned)ldg + (unsigned)(col0 + bj * HALF)) * 2u;
                    float ga[8], gb[8]; unpack8(ga, *(const u32x4*)((const char*)gate + goff)); unpack8(gb, *(const u32x4*)((const char*)gate + 2048 + goff));
#pragma unroll
                    for (int e = 0; e < 4; ++e) { acc[ai][bj][m][0][e] *= ga[e] * __builtin_amdgcn_rcpf(gb[e]); acc[ai][bj][m][1][e] *= ga[4 + e] * __builtin_amdgcn_rcpf(gb[4 + e]); }
                    asm volatile("" : "+v"(acc[ai][bj][m][0]), "+v"(acc[ai][bj][m][1]) :: "memory");
                }
    }
    __device__ __forceinline__ void operator()(const f32x4 (&acc)[2][2][4][2], const Unit& u, int wr, int wc, int fr, int fq) const {
        const int row0 = u.pm * BM + wr * 64 + fr, col0 = u.pn * BM + wc * 32 + 8 * fq;
#pragma unroll
        for (int ai = 0; ai < 2; ++ai)
#pragma unroll
            for (int m = 0; m < 4; ++m)
#pragma unroll
                for (int bj = 0; bj < 2; ++bj) {
                    const int row = row0 + ai * HALF + m * 16, col = col0 + bj * HALF;
                    float gb[8]; unpack8(gb, *(const u32x4*)((const char*)gate + 2048 + ((unsigned)row * (unsigned)ldg + (unsigned)col) * 2u));
                    const f32x4 a0 = acc[ai][bj][m][0], a1 = acc[ai][bj][m][1];
                    u32x4 w; w.x = cvt_pk_bf16(a0[0] * gb[0], a0[1] * gb[1]); w.y = cvt_pk_bf16(a0[2] * gb[2], a0[3] * gb[3]); w.z = cvt_pk_bf16(a1[0] * gb[4], a1[1] * gb[5]); w.w = cvt_pk_bf16(a1[2] * gb[6], a1[3] * gb[7]);
                    *(u32x4*)(MO + (size_t)row * 1024 + col) = w;
                }
    }
};
struct EpiXS {
    static constexpr bool PERM = true;
    bf16_t* P; float* L;
    __device__ __forceinline__ void operator()(const f32x4 (&acc)[2][2][4][2], const Unit& u, int wr, int wc, int fr, int fq) const {
        const int row0 = u.pm * BM + wr * 64 + fr, col0 = u.pn * BM + wc * 32 + 8 * fq;
#pragma unroll
        for (int ai = 0; ai < 2; ++ai)
#pragma unroll
            for (int m = 0; m < 4; ++m) {
                const int row = row0 + ai * HALF + m * 16; float rsum = 0.f;
#pragma unroll
                for (int bj = 0; bj < 2; ++bj) {
                    float h[8];
#pragma unroll
                    for (int n = 0; n < 2; ++n)
#pragma unroll
                        for (int e = 0; e < 4; ++e) { const float pe = __builtin_amdgcn_exp2f(fminf(acc[ai][bj][m][n][e], 100.f)); h[n * 4 + e] = pe; rsum += pe; }
                    u32x4 w; w.x = cvt_pk_bf16(h[0], h[1]); w.y = cvt_pk_bf16(h[2], h[3]); w.z = cvt_pk_bf16(h[4], h[5]); w.w = cvt_pk_bf16(h[6], h[7]);
                    *(u32x4*)(P + (size_t)row * 1024 + col0 + bj * HALF) = w;
                }
                rsum += __shfl_xor(rsum, 16); rsum += __shfl_xor(rsum, 32);
                if (fq == 0) L[((size_t)row * 4 + u.pn) * 4 + wc] = rsum;
            }
    }
};

template <class E, class = void> struct epi_has_hook { static constexpr bool value = false; };
template <class E> struct epi_has_hook<E, decltype((void)E::HOOK)> { static constexpr bool value = E::HOOK; };
template <class Epi, class Sched>
__device__ __forceinline__ void gemm_phase(PG8_LAS unsigned char* lds, const Gemm g, const Sched& S, const Epi& E) {
    int tid = threadIdx.x; asm volatile("" : "+v"(tid));
    const int wid = __builtin_amdgcn_readfirstlane(tid >> 6), lane = tid & 63, wr = wid >> 2, wc = wid & 3, fr = lane & 15, fq = lane >> 4;
    const int K = g.K, nt = K / BK;
    unsigned voffA[2], voffB[2];
#pragma unroll
    for (int i = 0; i < 2; ++i) { int R, C; stage_rc(tid * 16 + i * 8192, R, C); const int Rb = Epi::PERM ? ((R & ~31) + perm32(R & 31)) : R;
        voffA[i] = (unsigned)(R * g.lda + C) * 2u; voffB[i] = (unsigned)(Rb * g.ldb + C) * 2u; }
    const size_t kstep = (size_t)(BK * 2), kstepA = (size_t)g.ksa;
    const size_t hstepA = (size_t)HALF * g.lda * 2, hstepB = (size_t)HALF * g.ldb * 2;
    const unsigned ldsw = (unsigned)wid * 1024u;
    const int aoff = lds_byte(wr * 64 + fr, fq * 8), boff = lds_byte(wc * 32 + fr, fq * 8);
#define PG8_SA(b, h) (((b) * 2 + (h)) * HTB)
#define PG8_SB(b, h) ((4 + (b) * 2 + (h)) * HTB)
#define PG8_STAGE(bufoff, gbase, voff) do { _Pragma("unroll") for (int _i = 0; _i < 2; ++_i) \
        __builtin_amdgcn_global_load_lds((const unsigned*)((const char*)(gbase) + (voff)[_i]), (PG8_LAS unsigned*)(lds + (bufoff) + ldsw + _i * 8192), 16, 0, 0); } while (0)
#define PG8_LDA(dst, b, h) do { _Pragma("unroll") for (int m = 0; m < 4; ++m) _Pragma("unroll") for (int k = 0; k < 2; ++k) dst[m][k] = *(const PG8_LAS bf16x8*)(lds + PG8_SA(b, h) + aoff + m * 2048 + k * 1024); } while (0)
#define PG8_LDB(dst, b, h) do { _Pragma("unroll") for (int n = 0; n < 2; ++n) _Pragma("unroll") for (int k = 0; k < 2; ++k) dst[n][k] = *(const PG8_LAS bf16x8*)(lds + PG8_SB(b, h) + boff + n * 2048 + k * 1024); } while (0)
#define PG8_MMA(ai, bj, At, Bt) do { __builtin_amdgcn_s_setprio(1); _Pragma("unroll") for (int m = 0; m < 4; ++m) _Pragma("unroll") for (int n = 0; n < 2; ++n) _Pragma("unroll") for (int k = 0; k < 2; ++k) \
        acc[ai][bj][m][n] = __builtin_amdgcn_mfma_f32_16x16x32_bf16(Bt[n][k], At[m][k], acc[ai][bj][m][n], 0, 0, 0); __builtin_amdgcn_s_setprio(0); } while (0)
#define PG8_WAIT_V(n) asm volatile("s_waitcnt vmcnt(" #n ")" ::: "memory")
#define PG8_WAIT_L(n) asm volatile("s_waitcnt lgkmcnt(" #n ")" ::: "memory")
#define PG8_BAR __builtin_amdgcn_s_barrier()
#define PG8_SCHED __builtin_amdgcn_sched_barrier(0)
    Unit cur, nxt; int ui = 0;
    if (!S.next(0, cur)) return;
    f32x4 acc[2][2][4][2];
#pragma unroll
    for (int a = 0; a < 2; ++a)
#pragma unroll
        for (int b = 0; b < 2; ++b)
#pragma unroll
            for (int m = 0; m < 4; ++m)
#pragma unroll
                for (int n = 0; n < 2; ++n) acc[a][b][m][n] = (f32x4){0.f, 0.f, 0.f, 0.f};
    bf16x8 At[4][2], B0[2][2], B1[2][2];
    const char* cA = (const char*)g.A + (size_t)cur.aoff * 2; const char* cB = (const char*)g.Bt + (size_t)cur.boff * 2;
    PG8_STAGE(PG8_SB(0, 0), cB, voffB); PG8_STAGE(PG8_SB(0, 1), cB + hstepB, voffB); PG8_STAGE(PG8_SA(0, 0), cA, voffA); PG8_STAGE(PG8_SA(0, 1), cA + hstepA, voffA);
    if (wr == 1) PG8_BAR;
    PG8_WAIT_V(2); PG8_BAR;
    PG8_STAGE(PG8_SB(1, 0), cB + kstep, voffB); PG8_STAGE(PG8_SA(1, 0), cA + kstepA, voffA); PG8_STAGE(PG8_SB(1, 1), cB + hstepB + kstep, voffB);
    PG8_WAIT_V(6); PG8_BAR;
    for (;;) {
        const bool has_next = S.next(ui + 1, nxt);
        const char* nA = has_next ? (const char*)g.A + (size_t)nxt.aoff * 2 : cA; const char* nB = has_next ? (const char*)g.Bt + (size_t)nxt.boff * 2 : cB;
#pragma nounroll
        for (int t = 0; t < nt; t += 2) {
            const bool last = (t == nt - 2);
            const char* a1 = cA + (size_t)(t + 1) * kstepA;
            const char* a2 = last ? nA : cA + (size_t)(t + 2) * kstepA; const char* b2 = last ? nB : cB + (size_t)(t + 2) * kstep;
            const char* a3 = a2 + kstepA; const char* b3 = b2 + kstep;
            if constexpr (epi_has_hook<Epi>::value) { if (t == nt / 2) E.hook(acc, cur, wr, wc, fr, fq); }
            PG8_LDB(B0, 0, 0); PG8_LDB(B1, 0, 1); PG8_SCHED; PG8_LDA(At, 0, 0); PG8_STAGE(PG8_SA(1, 1), a1 + hstepA, voffA);
            PG8_WAIT_V(8); PG8_WAIT_L(0); PG8_BAR; PG8_MMA(0, 0, At, B0); PG8_MMA(0, 1, At, B1); PG8_BAR; PG8_SCHED;
            PG8_LDA(At, 0, 1); PG8_STAGE(PG8_SB(0, 0), b2, voffB); PG8_STAGE(PG8_SB(0, 1), b2 + hstepB, voffB); PG8_STAGE(PG8_SA(0, 0), a2, voffA);
            PG8_WAIT_V(8); PG8_WAIT_L(0); PG8_BAR; PG8_MMA(1, 0, At, B0); PG8_MMA(1, 1, At, B1); PG8_BAR; PG8_SCHED;
            PG8_LDB(B0, 1, 0); PG8_LDB(B1, 1, 1); PG8_SCHED; PG8_LDA(At, 1, 0); PG8_STAGE(PG8_SA(0, 1), a2 + hstepA, voffA);
            PG8_WAIT_V(8); PG8_WAIT_L(0); PG8_BAR; PG8_MMA(0, 0, At, B0); PG8_MMA(0, 1, At, B1); PG8_BAR; PG8_SCHED;
            PG8_LDA(At, 1, 1); PG8_STAGE(PG8_SB(1, 0), b3, voffB); PG8_STAGE(PG8_SB(1, 1), b3 + hstepB, voffB); PG8_STAGE(PG8_SA(1, 0), a3, voffA);
            PG8_WAIT_V(8); PG8_WAIT_L(0); PG8_BAR; PG8_MMA(1, 0, At, B0); PG8_MMA(1, 1, At, B1); PG8_BAR; PG8_SCHED;
        }
        if (wr == 0) PG8_BAR;
        E(acc, cur, wr, wc, fr, fq);
        if (!has_next) break;
#pragma unroll
        for (int a = 0; a < 2; ++a)
#pragma unroll
            for (int b = 0; b < 2; ++b)
#pragma unroll
                for (int m = 0; m < 4; ++m)
#pragma unroll
                    for (int n = 0; n < 2; ++n) acc[a][b][m][n] = (f32x4){0.f, 0.f, 0.f, 0.f};
        cur = nxt; cA = nA; cB = nB; ++ui;
        if (wr == 1) PG8_BAR;
    }
    PG8_WAIT_V(0);
    PG8_BAR;
#undef PG8_SA
#undef PG8_SB
#undef PG8_STAGE
#undef PG8_LDA
#undef PG8_LDB
#undef PG8_MMA
#undef PG8_WAIT_V
#undef PG8_WAIT_L
#undef PG8_BAR
#undef PG8_SCHED
}
}

using pg8::bf16_t; using pg8::bf16x8; using pg8::f32x4; using pg8::u32x4; using pg8::u32x2;
using pg8::cvt_pk_bf16; using pg8::bf2f; using pg8::fsigmoid;

constexpr int M = 65536, DM = 1024, DFF = 2816, SEQ = 8192;
constexpr size_t MiB = 1u << 20;
constexpr size_t WS_L = 0, WS_CB = 64 * 1024;
constexpr size_t WS_W1GU = 1 * MiB, WS_W1D = 12 * MiB, WS_W2GU = 18 * MiB, WS_W2D = 29 * MiB, WS_WIN = 35 * MiB, WS_WC1 = 44 * MiB, WS_WC2 = 46 * MiB,
                 WS_WUA = 47 * MiB, WS_WUB = 48 * MiB, WS_WOUT = 49 * MiB, WS_WXQ = 51 * MiB, WS_WXKV = 53 * MiB, WS_WXO = 57 * MiB;
constexpr size_t WS_OA = 65 * MiB, WS_XN = 321 * MiB, WS_R = 449 * MiB;
constexpr size_t WS_H = WS_R, WS_PQ = WS_R, WS_PG = 737 * MiB, WS_MERGED = WS_R, WS_QX = WS_R, WS_PX = 577 * MiB, WS_OX = 705 * MiB;
constexpr size_t WS_MEMN = 993 * MiB, WS_KM = 997 * MiB, WS_VMT = 1001 * MiB, WS_SS = 1005 * MiB, WS_LP = 1017 * MiB, WS_END = 1021 * MiB;
constexpr size_t DO_ACMP = 0, DO_HC = 64 * MiB, DO_KC = 72 * MiB, DO_VCT = 73 * MiB, DO_KVS = 80 * MiB, DO_KVW = 112 * MiB, DO_KVB = 144 * MiB, DO_T = 0;
constexpr int PQ_LD = 2304, PG_LD = 2048;
constexpr int BAR_LDS_OFF = 147456 - 16;
constexpr size_t BAR_BYTES = 16384;
constexpr float LOG2E = 1.4426950408889634f;

__device__ const unsigned char BUCKET_TAB[128] = {0, 1, 2, 3, 4, 5, 6, 7, 8, 9, 10, 11, 12, 13, 14, 15, 16, 16, 16, 17, 17, 18, 18, 18, 19, 19, 19, 20, 20, 20, 20, 21, 21, 21, 21, 22, 22, 22, 22, 22, 23, 23, 23, 23, 23, 23, 24, 24, 24, 24, 24, 24, 25, 25, 25, 25, 25, 25, 25, 26, 26, 26, 26, 26, 26, 26, 26, 27, 27, 27, 27, 27, 27, 27, 27, 27, 27, 28, 28, 28, 28, 28, 28, 28, 28, 28, 28, 29, 29, 29, 29, 29, 29, 29, 29, 29, 29, 29, 29, 30, 30, 30, 30, 30, 30, 30, 30, 30, 30, 30, 30, 30, 30, 31, 31, 31, 31, 31, 31, 31, 31, 31, 31, 31, 31, 31, 31, 31};

#define PROBE_ATT_A 1
#define REP_CMP 1
#define REP_TOPK 1
#define REP_SEL 1
#define REP_WIN 1
#define PROBE_ATT_B 1
struct Params { const float* in[29]; float* out; unsigned char* ws; };

__device__ __forceinline__ float wave_sum(float v) {
#pragma unroll
    for (int o = 1; o < 64; o <<= 1) v += __shfl_xor(v, o);
    return v;
}
__device__ __forceinline__ void conv_item(const float* W, int K, int N, bf16_t* WT, int ldd, int kofs, int kind, int roff, const float* gk, float* scr, int item, int lane) {
    const int nblk = (N + 31) / 32, kb = item / nblk, nb = item % nblk, k0 = 64 * kb, n0 = 32 * nb;
    const int nr = n0 + (lane & 31);
#pragma unroll 8
    for (int i = 0; i < 32; ++i) { const int kk = 2 * i + (lane >> 5); scr[kk * 33 + (lane & 31)] = (nr < N) ? W[(size_t)(k0 + kk) * N + nr] : 0.f; }
    asm volatile("s_waitcnt lgkmcnt(0)" ::: "memory");
    const int c = lane & 7;
#pragma unroll
    for (int j = 0; j < 4; ++j) {
        const int nl = (lane >> 3) + 8 * j, n = n0 + nl; const float* s = scr + (8 * c) * 33 + nl;
        int dr = n + roff; float sc = 1.0f;
        if (kind == 1) dr = (n >> 7) * 256 + (n & 127);
        else if (kind == 2) dr = (n >> 7) * 256 + 128 + (n & 127);
        else if (kind == 3) { dr = n < 2072 ? n : n + 232; if (n < 512 || (n >= 1304 && n < 1816)) sc = 0.125f * LOG2E; }
        else if (kind == 4) sc = 0.0625f * LOG2E;
        f32x4 g0 = (f32x4){sc, sc, sc, sc}, g1 = g0;
        if (gk) { g0 = *(const f32x4*)(gk + k0 + 8 * c) * sc; g1 = *(const f32x4*)(gk + k0 + 8 * c + 4) * sc; }
        u32x4 o; o.x = cvt_pk_bf16(s[0 * 33] * g0[0], s[1 * 33] * g0[1]); o.y = cvt_pk_bf16(s[2 * 33] * g0[2], s[3 * 33] * g0[3]); o.z = cvt_pk_bf16(s[4 * 33] * g1[0], s[5 * 33] * g1[1]); o.w = cvt_pk_bf16(s[6 * 33] * g1[2], s[7 * 33] * g1[3]);
        if (n < N) *(u32x4*)(WT + (size_t)dr * ldd + kofs + k0 + 8 * c) = o;
    }
    asm volatile("s_waitcnt lgkmcnt(0)" ::: "memory");
}
__device__ __forceinline__ void rms_row(const float* xrow, const float* g, bf16_t* orow, float* frow, int lane) {
    const f32x4* xr = (const f32x4*)xrow + lane; const f32x4* gr = (const f32x4*)g + lane;
    f32x4 v[4]; float s = 0.f;
#pragma unroll
    for (int j = 0; j < 4; ++j) { v[j] = xr[64 * j]; s += (v[j].x * v[j].x + v[j].y * v[j].y) + (v[j].z * v[j].z + v[j].w * v[j].w); }
    const float rstd = 1.0f / sqrtf(wave_sum(s) * (1.f / 1024.f) + 1e-6f);
#pragma unroll
    for (int j = 0; j < 4; ++j) {
        const f32x4 gg = gr[64 * j]; const f32x4 y = v[j] * rstd * gg;
        if (orow) { u32x2 w; w.x = cvt_pk_bf16(y.x, y.y); w.y = cvt_pk_bf16(y.z, y.w); *((u32x2*)orow + lane + 64 * j) = w; }
        else *((f32x4*)frow + lane + 64 * j) = y;
    }
}
__device__ __forceinline__ void rms_row_bf16(const bf16_t* xrow, const float* g, float* frow, int lane) {
    float v[2][8]; float s = 0.f;
#pragma unroll
    for (int j = 0; j < 2; ++j) { const u32x4 gw = *((const u32x4*)xrow + lane + 64 * j);
        v[j][0] = __uint_as_float(gw.x << 16); v[j][1] = __uint_as_float(gw.x & 0xffff0000u); v[j][2] = __uint_as_float(gw.y << 16); v[j][3] = __uint_as_float(gw.y & 0xffff0000u);
        v[j][4] = __uint_as_float(gw.z << 16); v[j][5] = __uint_as_float(gw.z & 0xffff0000u); v[j][6] = __uint_as_float(gw.w << 16); v[j][7] = __uint_as_float(gw.w & 0xffff0000u);
#pragma unroll
        for (int e = 0; e < 8; ++e) s += v[j][e] * v[j][e]; }
    const float rstd = 1.0f / sqrtf(wave_sum(s) * (1.f / 1024.f) + 1e-6f);
#pragma unroll
    for (int j = 0; j < 2; ++j) {
        const f32x4 g0 = *((const f32x4*)g + 2 * (lane + 64 * j)), g1 = *((const f32x4*)g + 2 * (lane + 64 * j) + 1);
        *((f32x4*)frow + 2 * (lane + 64 * j)) = (f32x4){v[j][0] * rstd * g0[0], v[j][1] * rstd * g0[1], v[j][2] * rstd * g0[2], v[j][3] * rstd * g0[3]};
        *((f32x4*)frow + 2 * (lane + 64 * j) + 1) = (f32x4){v[j][4] * rstd * g1[0], v[j][5] * rstd * g1[1], v[j][6] * rstd * g1[2], v[j][7] * rstd * g1[3]};
    }
}
__device__ __forceinline__ void rms_pass(const float* X, const float* g, bf16_t* O, float* F, int rows, int gw, int NGW) {
    int lane = threadIdx.x & 63; asm volatile("" : "+v"(lane));
    const f32x4* gr = (const f32x4*)g + lane;
    for (int m = gw; m < rows; m += 2 * NGW) {
        const bool two = (m + NGW) < rows; const int m1 = two ? m + NGW : m;
        const f32x4* x0 = (const f32x4*)(X + (size_t)m * 1024) + lane; const f32x4* x1 = (const f32x4*)(X + (size_t)m1 * 1024) + lane;
        f32x4 v0[4], v1[4]; float s0 = 0.f, s1 = 0.f;
#pragma unroll
        for (int j = 0; j < 4; ++j) { v0[j] = x0[64 * j]; v1[j] = x1[64 * j]; }
#pragma unroll
        for (int j = 0; j < 4; ++j) { s0 += (v0[j].x * v0[j].x + v0[j].y * v0[j].y) + (v0[j].z * v0[j].z + v0[j].w * v0[j].w); s1 += (v1[j].x * v1[j].x + v1[j].y * v1[j].y) + (v1[j].z * v1[j].z + v1[j].w * v1[j].w); }
        const float r0 = 1.0f / sqrtf(wave_sum(s0) * (1.f / 1024.f) + 1e-6f), r1 = 1.0f / sqrtf(wave_sum(s1) * (1.f / 1024.f) + 1e-6f);
#pragma unroll
        for (int j = 0; j < 4; ++j) {
            const f32x4 gg = gr[64 * j]; const f32x4 y0 = v0[j] * r0 * gg, y1 = v1[j] * r1 * gg;
            u32x2 w0, w1; w0.x = cvt_pk_bf16(y0.x, y0.y); w0.y = cvt_pk_bf16(y0.z, y0.w); w1.x = cvt_pk_bf16(y1.x, y1.y); w1.y = cvt_pk_bf16(y1.z, y1.w);
            *((u32x2*)(O + (size_t)m * 1024) + lane + 64 * j) = w0;
            if (two) *((u32x2*)(O + (size_t)m1 * 1024) + lane + 64 * j) = w1;
        }
    }
}
__device__ __forceinline__ void rms_final(const bf16_t* X, const float* g, float* out, int rows, int gw, int NGW) {
    int lane = threadIdx.x & 63; asm volatile("" : "+v"(lane));
    for (int m = gw; m < rows; m += 4 * NGW) {
        u32x4 raw[4][2];
#pragma unroll
        for (int k = 0; k < 4; ++k) { const int mk = (m + k * NGW) < rows ? m + k * NGW : m;
#pragma unroll
            for (int j = 0; j < 2; ++j) raw[k][j] = *((const u32x4*)(X + (size_t)mk * 1024) + lane + 64 * j); }
#pragma unroll
        for (int k = 0; k < 4; ++k) {
            float v[2][8]; float sq = 0.f;
#pragma unroll
            for (int j = 0; j < 2; ++j) { const u32x4 gw4 = raw[k][j];
                v[j][0] = __uint_as_float(gw4.x << 16); v[j][1] = __uint_as_float(gw4.x & 0xffff0000u); v[j][2] = __uint_as_float(gw4.y << 16); v[j][3] = __uint_as_float(gw4.y & 0xffff0000u);
                v[j][4] = __uint_as_float(gw4.z << 16); v[j][5] = __uint_as_float(gw4.z & 0xffff0000u); v[j][6] = __uint_as_float(gw4.w << 16); v[j][7] = __uint_as_float(gw4.w & 0xffff0000u);
#pragma unroll
                for (int e = 0; e < 8; ++e) sq += v[j][e] * v[j][e]; }
            const float rstd = 1.0f / sqrtf(wave_sum(sq) * (1.f / 1024.f) + 1e-6f);
            if ((m + k * NGW) < rows) {
                float* frow = out + (size_t)(m + k * NGW) * 1024;
#pragma unroll
                for (int j = 0; j < 2; ++j) {
                    const f32x4 g0 = *((const f32x4*)g + 2 * (lane + 64 * j)), g1 = *((const f32x4*)g + 2 * (lane + 64 * j) + 1);
                    *((f32x4*)frow + 2 * (lane + 64 * j)) = (f32x4){v[j][0] * rstd * g0[0], v[j][1] * rstd * g0[1], v[j][2] * rstd * g0[2], v[j][3] * rstd * g0[3]};
                    *((f32x4*)frow + 2 * (lane + 64 * j) + 1) = (f32x4){v[j][4] * rstd * g1[0], v[j][5] * rstd * g1[1], v[j][6] * rstd * g1[2], v[j][7] * rstd * g1[3]};
                }
            }
        }
    }
}

namespace att {
constexpr int SLOTB = 16384, NSLOT = 4;
constexpr int OFF_RING = 0, OFF_BT = NSLOT * SLOTB, OFF_SEL = OFF_BT + 129 * 16 * 4 + 192, OFF_IMP = OFF_SEL + 64 * 4 * 4, IMP_LD = 129, OFF_STASH = OFF_IMP, ATT_LDS = OFF_STASH + 32 * 512 * 4;
static_assert(OFF_IMP % 16 == 0 && 64 * IMP_LD * 4 <= 32 * 512 * 4 && ATT_LDS <= 147456, "attention LDS map");
struct Args { const bf16_t* PQ; const bf16_t* KC; const bf16_t* VCT; const bf16_t* KVS; const bf16_t* KVW; const bf16_t* KVB; bf16_t* OA; bf16_t* OB; const float* sinks; };

__device__ __forceinline__ int prow(int f, int r) { return 32 * (f >> 1) + 8 * (r >> 2) + 4 * (f & 1) + (r & 3); }
__device__ __forceinline__ int swz(int R) { return (R & 2) | ((R & 8) >> 1); }
__device__ __forceinline__ unsigned src_off(int w, int lane, int ldB) { const int R = 8 * w + (lane >> 3), cch = (lane & 7) ^ swz(R); return (unsigned)(R * ldB + cch * 16); }
__device__ __forceinline__ void glds16(const void* gsrc, unsigned lds_dst) { unsigned keep;
    asm volatile("s_mov_b32 %0, m0\n\ts_mov_b32 m0, %2\n\ts_nop 0\n\tglobal_load_lds_dwordx4 %1, off\n\ts_mov_b32 m0, %0" : "=&s"(keep) : "v"(gsrc), "s"(lds_dst) : "memory"); }
__device__ __forceinline__ void dma_block(PG8_LAS unsigned char* lds3, int slot, int wu, const unsigned char* Kblk, unsigned koff, const unsigned char* Vblk, unsigned voff) {
    const unsigned base = (unsigned)(__UINTPTR_TYPE__)lds3 + OFF_RING + slot * SLOTB + wu * 1024;
    glds16(Kblk + koff, (unsigned)__builtin_amdgcn_readfirstlane(base));
    glds16(Vblk + voff, (unsigned)__builtin_amdgcn_readfirstlane(base + 8192));
}
__device__ __forceinline__ void ring_wait_bar(int young) {
    if (young >= 2) asm volatile("s_waitcnt vmcnt(4)" ::: "memory"); else if (young == 1) asm volatile("s_waitcnt vmcnt(2)" ::: "memory"); else asm volatile("s_waitcnt vmcnt(0)" ::: "memory");
    asm volatile("s_waitcnt lgkmcnt(0)" ::: "memory");
    __builtin_amdgcn_s_barrier();
    asm volatile("" ::: "memory");
}
__device__ __forceinline__ void load_kfrags(bf16x8 (&kf)[4][2], const unsigned char* Ks, int r, int fq) {
#pragma unroll
    for (int f = 0; f < 4; ++f)
#pragma unroll
        for (int dc = 0; dc < 2; ++dc) { const int R = prow(f, r); kf[f][dc] = *(const bf16x8*)(Ks + R * 128 + (((4 * dc + fq) ^ swz(R)) << 4)); }
}
__device__ __forceinline__ void qk(f32x4 (&s)[4], const bf16x8 (&kf)[4][2], const bf16x8 (&q)[2], float cinit) {
#pragma unroll
    for (int f = 0; f < 4; ++f) {
        s[f] = (f32x4){cinit, cinit, cinit, cinit};
#pragma unroll
        for (int dc = 0; dc < 2; ++dc) s[f] = __builtin_amdgcn_mfma_f32_16x16x32_bf16(kf[f][dc], q[dc], s[f], 0, 0, 0);
    }
}
__device__ __forceinline__ void pv(f32x4 (&o)[4], const float (&p)[4][4], const unsigned char* Vs, int r, int fq) {
    bf16x8 pb[2];
#pragma unroll
    for (int kc = 0; kc < 2; ++kc) {
        u32x4 w; w.x = cvt_pk_bf16(p[2 * kc][0], p[2 * kc][1]); w.y = cvt_pk_bf16(p[2 * kc][2], p[2 * kc][3]); w.z = cvt_pk_bf16(p[2 * kc + 1][0], p[2 * kc + 1][1]); w.w = cvt_pk_bf16(p[2 * kc + 1][2], p[2 * kc + 1][3]);
        pb[kc] = __builtin_bit_cast(bf16x8, w);
    }
#pragma unroll
    for (int df = 0; df < 4; ++df)
#pragma unroll
        for (int kc = 0; kc < 2; ++kc) {
            const int R = prow(df, r);
            const bf16x8 vf = *(const bf16x8*)(Vs + R * 128 + (((4 * kc + fq) ^ swz(R)) << 4));
            o[df] = __builtin_amdgcn_mfma_f32_16x16x32_bf16(vf, pb[kc], o[df], 0, 0, 0);
        }
}
__device__ __forceinline__ void logits(float (&v)[4][4], const f32x4 (&s)[4], int tq, int kpos0, int kstride, int fq, int H, const float* btab, float farb, bool use_tab, int wl) {
#pragma unroll
    for (int f = 0; f < 4; ++f)
#pragma unroll
        for (int i = 0; i < 4; ++i) {
            const int kk = 32 * (f >> 1) + 8 * fq + 4 * (f & 1) + i;
            const int dist = tq - (kpos0 + kstride * kk);
            const bool ok = dist >= 0 && dist < wl;
            const int di = dist < 0 ? 0 : (dist > 128 ? 128 : dist);
            v[f][i] = ok ? s[f][i] + btab[di * 16 + H] : -1e30f;
        }
}
__device__ __forceinline__ float red_max4(float x) {
    auto a = __builtin_amdgcn_permlane16_swap(__float_as_uint(x), __float_as_uint(x), false, false); x = fmaxf(__uint_as_float(a[0]), __uint_as_float(a[1]));
    auto b = __builtin_amdgcn_permlane32_swap(__float_as_uint(x), __float_as_uint(x), false, false); return fmaxf(__uint_as_float(b[0]), __uint_as_float(b[1]));
}
__device__ __forceinline__ float quad_sum(float x) {
    auto a = __builtin_amdgcn_permlane16_swap(__float_as_uint(x), __float_as_uint(x), false, false); x = __uint_as_float(a[0]) + __uint_as_float(a[1]);
    auto b = __builtin_amdgcn_permlane32_swap(__float_as_uint(x), __float_as_uint(x), false, false); return __uint_as_float(b[0]) + __uint_as_float(b[1]);
}
__device__ __forceinline__ float dpp_xor1(float x) { return __builtin_bit_cast(float, __builtin_amdgcn_update_dpp(0, __builtin_bit_cast(int, x), 0xB1, 0xF, 0xF, true)); }
__device__ __forceinline__ float dpp_xor2(float x) { return __builtin_bit_cast(float, __builtin_amdgcn_update_dpp(0, __builtin_bit_cast(int, x), 0x4E, 0xF, 0xF, true)); }
__device__ __forceinline__ float max16(const float (&v)[4][4]) {
    float a = fmaxf(fmaxf(v[0][0], v[0][1]), fmaxf(v[0][2], v[0][3])), b = fmaxf(fmaxf(v[1][0], v[1][1]), fmaxf(v[1][2], v[1][3]));
    float c = fmaxf(fmaxf(v[2][0], v[2][1]), fmaxf(v[2][2], v[2][3])), d = fmaxf(fmaxf(v[3][0], v[3][1]), fmaxf(v[3][2], v[3][3]));
    return fmaxf(fmaxf(a, b), fmaxf(c, d));
}
__device__ __forceinline__ float max3f(float a, float b, float c) { float r; asm("v_max3_f32 %0, %1, %2, %3" : "=v"(r) : "v"(a), "v"(b), "v"(c)); return r; }
__device__ __forceinline__ float max16v(const f32x4 (&s)[4]) {
    float a = max3f(s[0][0], s[0][1], s[0][2]), b = max3f(s[0][3], s[1][0], s[1][1]), c = max3f(s[1][2], s[1][3], s[2][0]), d = max3f(s[2][1], s[2][2], s[2][3]);
    a = max3f(a, s[3][0], s[3][1]); b = max3f(b, s[3][2], s[3][3]); return max3f(max3f(a, b, c), d, d);
}
template <int CGM>
__device__ __forceinline__ void pv2(f32x4 (&o)[2][4], const float (&p)[2][4][4], const unsigned char* Vs, int r, int fq) {
    bf16x8 pb[2][2];
#pragma unroll
    for (int cg_ = 0; cg_ < 2; ++cg_) if ((CGM >> cg_) & 1)
#pragma unroll
        for (int kc = 0; kc < 2; ++kc) {
            u32x4 w; w.x = cvt_pk_bf16(p[cg_][2 * kc][0], p[cg_][2 * kc][1]); w.y = cvt_pk_bf16(p[cg_][2 * kc][2], p[cg_][2 * kc][3]);
            w.z = cvt_pk_bf16(p[cg_][2 * kc + 1][0], p[cg_][2 * kc + 1][1]); w.w = cvt_pk_bf16(p[cg_][2 * kc + 1][2], p[cg_][2 * kc + 1][3]);
            pb[cg_][kc] = __builtin_bit_cast(bf16x8, w);
        }
#pragma unroll
    for (int df = 0; df < 4; ++df)
#pragma unroll
        for (int kc = 0; kc < 2; ++kc) {
            const int R = prow(df, r);
            const bf16x8 vf = *(const bf16x8*)(Vs + R * 128 + (((4 * kc + fq) ^ swz(R)) << 4));
            if (CGM & 1) o[0][df] = __builtin_amdgcn_mfma_f32_16x16x32_bf16(vf, pb[0][kc], o[0][df], 0, 0, 0);
            if (CGM & 2) o[1][df] = __builtin_amdgcn_mfma_f32_16x16x32_bf16(vf, pb[1][kc], o[1][df], 0, 0, 0);
        }
}
template <int CGM>
__device__ __forceinline__ void step_edge(const bf16x8 (&kf)[4][2], const bf16x8 (&q)[2][2], const int (&tq)[2], int key0, int fq, int H, const float* btab, int wl, const bool (&selq)[2],
                                          float (&m)[2], float (&l)[2], f32x4 (&o)[2][4], const unsigned char* Vs, int r) {
    float v[2][4][4]; float mnew[2] = {m[0], m[1]};
#pragma unroll
    for (int cg_ = 0; cg_ < 2; ++cg_) if ((CGM >> cg_) & 1) {
        f32x4 s[4]; qk(s, kf, q[cg_], 0.f); logits(v[cg_], s, tq[cg_], key0, 1, fq, H, btab, 0.f, true, wl);
        float mx = red_max4(max16(v[cg_])); if (!selq[cg_]) mx = -1e30f; mnew[cg_] = fmaxf(m[cg_], mx);
    }
    if (__any(mnew[0] > m[0] || mnew[1] > m[1])) {
#pragma unroll
        for (int cg_ = 0; cg_ < 2; ++cg_) if ((CGM >> cg_) & 1) {
            const float sc = __builtin_amdgcn_exp2f(m[cg_] - mnew[cg_]); l[cg_] *= sc; m[cg_] = mnew[cg_];
#pragma unroll
            for (int df = 0; df < 4; ++df) o[cg_][df] *= sc;
        }
    }
#pragma unroll
    for (int cg_ = 0; cg_ < 2; ++cg_) if ((CGM >> cg_) & 1) {
        const float moff = selq[cg_] ? m[cg_] : 1e30f; float rs = 0.f;
#pragma unroll
        for (int f = 0; f < 4; ++f)
#pragma unroll
            for (int i = 0; i < 4; ++i) { const float pe = __builtin_amdgcn_exp2f(v[cg_][f][i] - moff); v[cg_][f][i] = pe; rs += pe; }
        l[cg_] += rs;
    }
    pv2<CGM>(o, v, Vs, r, fq);
}
template <int CGM>
__device__ __forceinline__ void step_int(const bf16x8 (&kf)[4][2], const bf16x8 (&q)[2][2], float farb, const bool (&selq)[2],
                                         float (&m)[2], float (&l)[2], f32x4 (&o)[2][4], const unsigned char* Vs, int r, int fq) {
    f32x4 s[2][4]; float mx[2] = {-1e30f, -1e30f};
#pragma unroll
    for (int cg_ = 0; cg_ < 2; ++cg_) if ((CGM >> cg_) & 1) { qk(s[cg_], kf, q[cg_], selq[cg_] ? farb - m[cg_] : -1e30f); mx[cg_] = red_max4(max16v(s[cg_])); }
    if (__any(mx[0] > 0.f || mx[1] > 0.f)) {
#pragma unroll
        for (int cg_ = 0; cg_ < 2; ++cg_) if ((CGM >> cg_) & 1) {
            const float d = fmaxf(mx[cg_], 0.f), sc = __builtin_amdgcn_exp2f(-d); m[cg_] += d; l[cg_] *= sc;
#pragma unroll
            for (int df = 0; df < 4; ++df) o[cg_][df] *= sc;
#pragma unroll
            for (int f = 0; f < 4; ++f) s[cg_][f] -= d;
        }
    }
    float p[2][4][4];
#pragma unroll
    for (int cg_ = 0; cg_ < 2; ++cg_) if ((CGM >> cg_) & 1) {
        float rs = 0.f;
#pragma unroll
        for (int f = 0; f < 4; ++f)
#pragma unroll
            for (int i = 0; i < 4; ++i) { const float pe = __builtin_amdgcn_exp2f(s[cg_][f][i]); p[cg_][f][i] = pe; rs += pe; }
        l[cg_] += rs;
    }
    pv2<CGM>(o, p, Vs, r, fq);
}

template <bool SEL>
__device__ __forceinline__ void band_loop(unsigned char* lds, PG8_LAS unsigned char* lds3, const unsigned char* KV, int jhi, int jlo, int T, int wl,
                                          const bf16x8 (&q)[2][2], const int (&tq)[2], const unsigned long long (&sw)[2][2], int H, float farb,
                                          float (&m)[2], float (&l)[2], f32x4 (&o)[2][4], int wu, unsigned soff, int r, int fq) {
    const float* btab = (const float*)(lds + OFF_BT);
    const int n = jhi - jlo + 1;
    __syncthreads();
#pragma unroll
    for (int pi = 0; pi < 2; ++pi) if (pi < n) { const unsigned char* blk = KV + (size_t)(jhi - pi) * SLOTB; dma_block(lds3, pi, wu, blk, soff, blk + 8192, soff); }
    for (int it0 = 0; it0 < n; it0 += 2) {
        ring_wait_bar(0);
#pragma unroll
        for (int pi = 2; pi < 4; ++pi) if (it0 + pi < n) { const unsigned char* blk = KV + (size_t)(jhi - it0 - pi) * SLOTB; dma_block(lds3, (it0 + pi) & 3, wu, blk, soff, blk + 8192, soff); }
#pragma unroll 1
        for (int it = it0; it < it0 + 2 && it < n; ++it) {
            const int j = jhi - it, slot = it & 3;
            bool selq[2] = {true, true}; bool any[2] = {true, true};
            if (SEL) {
#pragma unroll
                for (int cg_ = 0; cg_ < 2; ++cg_) {
                    const unsigned long long wsel = j < 64 ? sw[cg_][0] : sw[cg_][1];
                    selq[cg_] = ((wsel >> (j & 63)) & 1ull) != 0ull; any[cg_] = __any(selq[cg_]) != 0;
                }
            }
            if (any[0] || any[1]) {
                const unsigned char* Ks = lds + OFF_RING + slot * SLOTB; const unsigned char* Vs = Ks + 8192;
                bf16x8 kf[4][2]; load_kfrags(kf, Ks, r, fq);
                const bool edge = (j >= T - 2) || (wl == 512 && j == T - 8);
                if (edge) {
                    if (any[0] && any[1]) step_edge<3>(kf, q, tq, j * 64, fq, H, btab, wl, selq, m, l, o, Vs, r);
                    else if (any[0]) step_edge<1>(kf, q, tq, j * 64, fq, H, btab, wl, selq, m, l, o, Vs, r);
                    else step_edge<2>(kf, q, tq, j * 64, fq, H, btab, wl, selq, m, l, o, Vs, r);
                } else {
                    if (any[0] && any[1]) step_int<3>(kf, q, farb, selq, m, l, o, Vs, r, fq);
                    else if (any[0]) step_int<1>(kf, q, farb, selq, m, l, o, Vs, r, fq);
                    else step_int<2>(kf, q, farb, selq, m, l, o, Vs, r, fq);
                }
            }
        }
    }
}

__device__ __forceinline__ void unitA(unsigned char* lds, PG8_LAS unsigned char* lds3, const Args& a, int b, int g, int T) {
    int tid = threadIdx.x; asm volatile("" : "+v"(tid));
    const int w = tid >> 6, wu = __builtin_amdgcn_readfirstlane(w), lane = tid & 63, c = lane & 15, fq = lane >> 4, hl = c & 3, r = c;
    const int H = 4 * g + hl, t0 = T * 64, bg = b * 2 + g;
    float* btab = (float*)(lds + OFF_BT); float* imp = (float*)(lds + OFF_IMP); unsigned* selm = (unsigned*)(lds + OFF_SEL);
    int tq[2]; bf16x8 q[2][2];
    f32x4* stash = (f32x4*)(lds + OFF_STASH);
#pragma unroll
    for (int cg_ = 0; cg_ < 2; ++cg_) {
        tq[cg_] = t0 + 8 * w + 4 * cg_ + (c >> 2);
        const bf16_t* rowp = a.PQ + (size_t)(b * SEQ + tq[cg_]) * PQ_LD;
#pragma unroll
        for (int dc = 0; dc < 2; ++dc) q[cg_][dc] = *(const bf16x8*)(rowp + H * 64 + 32 * dc + 8 * fq);
    }
#pragma unroll
    for (int cg_ = 0; cg_ < 2; ++cg_)
#pragma unroll
        for (int dc = 0; dc < 2; ++dc) asm volatile("" : "+v"(q[cg_][dc]));
    float gatev[3][2];
#pragma unroll
    for (int cg_ = 0; cg_ < 2; ++cg_)
#pragma unroll
        for (int br = 0; br < 3; ++br) { gatev[br][cg_] = bf2f(a.PQ[(size_t)(b * SEQ + tq[cg_]) * PQ_LD + 1280 + br * 8 + H]); asm volatile("" : "+v"(gatev[br][cg_])); }
#define GATE(br, cg_) fsigmoid(gatev[br][cg_])
    const float farb = btab[128 * 16 + H];
    const unsigned soff = src_off(w, lane, 128);
    __syncthreads();
    for (int i = tid; i < 64 * IMP_LD; i += 512) imp[i] = 0.f;
    f32x4 oc[2][4];
    for (int rep_ = 0; rep_ < REP_CMP; ++rep_) {
        const int NB = ((4 * T + 2) >> 6) + 1;
        const int ib_far = (64 * T - 1167) >= 0 ? (64 * T - 1167) / 1024 : -1;
        const unsigned char* Kb = (const unsigned char*)(a.KC + (size_t)bg * 512 * 64); const unsigned char* Vb = (const unsigned char*)(a.VCT + (size_t)bg * 64 * 512);
        const unsigned voffc = src_off(w, lane, 1024);
        float m[2] = {-1e30f, -1e30f}, l[2] = {0.f, 0.f}, moff[2];
        __syncthreads();
#pragma unroll
        for (int pi = 0; pi < 3; ++pi) if (pi < NB) dma_block(lds3, pi, wu, Kb + (size_t)pi * 8192, soff, Vb + pi * 128, voffc);
        for (int ib = 0; ib < NB; ++ib) {
            ring_wait_bar(NB - 1 - ib);
            if (ib + 3 < NB) dma_block(lds3, (ib + 3) & 3, wu, Kb + (size_t)(ib + 3) * 8192, soff, Vb + (ib + 3) * 128, voffc);
            const unsigned char* Ks = lds + OFF_RING + (ib & 3) * SLOTB;
            bf16x8 kf[4][2]; load_kfrags(kf, Ks, r, fq);
            const bool edge = ib > ib_far;
#pragma unroll
            for (int cg_ = 0; cg_ < 2; ++cg_) {
                f32x4 s[4]; float v[4][4];
                if (edge) { qk(s, kf, q[cg_], 0.f); logits(v, s, tq[cg_], 16 * 64 * ib + 31, 16, fq, H, btab, farb, true, 1 << 30); }
                else { qk(s, kf, q[cg_], farb);
#pragma unroll
                    for (int f = 0; f < 4; ++f)
#pragma unroll
                        for (int i = 0; i < 4; ++i) v[f][i] = s[f][i]; }
                const float mx = red_max4(max16(v)), mnew = fmaxf(m[cg_], mx), sc = __builtin_amdgcn_exp2f(m[cg_] - mnew); m[cg_] = mnew;
                float rs = 0.f;
#pragma unroll
                for (int f = 0; f < 4; ++f)
#pragma unroll
                    for (int i = 0; i < 4; ++i) rs += v[f][i] > -1e29f ? __builtin_amdgcn_exp2f(v[f][i] - mnew) : 0.f;
                l[cg_] = l[cg_] * sc + rs;
            }
        }
#pragma unroll
        for (int cg_ = 0; cg_ < 2; ++cg_) { const float lt = quad_sum(l[cg_]); moff[cg_] = lt > 0.f ? m[cg_] + __builtin_amdgcn_logf(lt) : 1e30f; }
#pragma unroll
        for (int cg_ = 0; cg_ < 2; ++cg_)
#pragma unroll
            for (int df = 0; df < 4; ++df) oc[cg_][df] = (f32x4){0.f, 0.f, 0.f, 0.f};
        __syncthreads();
#pragma unroll
        for (int pi = 0; pi < 3; ++pi) if (pi < NB) dma_block(lds3, pi, wu, Kb + (size_t)pi * 8192, soff, Vb + pi * 128, voffc);
        for (int ib = 0; ib < NB; ++ib) {
            ring_wait_bar(NB - 1 - ib);
            if (ib + 3 < NB) dma_block(lds3, (ib + 3) & 3, wu, Kb + (size_t)(ib + 3) * 8192, soff, Vb + (ib + 3) * 128, voffc);
            const unsigned char* Ks = lds + OFF_RING + (ib & 3) * SLOTB; const unsigned char* Vs = Ks + 8192;
            bf16x8 kf[4][2]; load_kfrags(kf, Ks, r, fq);
            const bool edge = ib > ib_far;
#pragma unroll
            for (int cg_ = 0; cg_ < 2; ++cg_) {
                f32x4 s[4]; float v[4][4];
                if (edge) { qk(s, kf, q[cg_], 0.f); logits(v, s, tq[cg_], 16 * 64 * ib + 31, 16, fq, H, btab, farb, true, 1 << 30);
#pragma unroll
                    for (int f = 0; f < 4; ++f)
#pragma unroll
                        for (int i = 0; i < 4; ++i) v[f][i] -= moff[cg_]; }
                else { qk(s, kf, q[cg_], farb - moff[cg_]);
#pragma unroll
                    for (int f = 0; f < 4; ++f)
#pragma unroll
                        for (int i = 0; i < 4; ++i) v[f][i] = s[f][i]; }
                const int qi = 8 * w + 4 * cg_ + (c >> 2);
#pragma unroll
                for (int f = 0; f < 4; ++f) {
#pragma unroll
                    for (int i = 0; i < 4; ++i) v[f][i] = __builtin_amdgcn_exp2f(v[f][i]);
                    float pa = v[f][0] + v[f][1] + v[f][2] + 0.5f * v[f][3], pb = 0.5f * v[f][3];
                    pa += dpp_xor1(pa); pa += dpp_xor2(pa); pb += dpp_xor1(pb); pb += dpp_xor2(pb);
                    if (hl == 0) { const int jj = 16 * ib + 8 * (f >> 1) + 2 * fq + (f & 1); atomicAdd(&imp[qi * IMP_LD + jj], pa); atomicAdd(&imp[qi * IMP_LD + jj + 1], pb); }
                }
                pv(oc[cg_], v, Vs, r, fq);
            }
        }
    }
    __syncthreads();
    for (int rep_ = 0; rep_ < REP_TOPK; ++rep_) {
        const int qi = 8 * w + (lane >> 3), gq = lane & 7;
        unsigned m16 = 0u;
        if (T <= 15) {
#pragma unroll
            for (int i = 0; i < 16; ++i) m16 |= (16 * gq + i <= T) ? (1u << i) : 0u;
        } else {
            unsigned u[16];
#pragma unroll
            for (int i = 0; i < 16; ++i) { const int j = 16 * gq + i; u[i] = (j >= 1 && j <= T - 2) ? __float_as_uint(imp[qi * IMP_LD + j]) : 0u; }
            unsigned thr = 0u;
            for (int bit = 30; bit >= 0; --bit) {
                const unsigned cand = thr | (1u << bit);
                int cnt = 0;
#pragma unroll
                for (int i = 0; i < 16; ++i) cnt += (u[i] >= cand) ? 1 : 0;
                cnt += __builtin_amdgcn_update_dpp(0, cnt, 0xB1, 0xF, 0xF, true); cnt += __builtin_amdgcn_update_dpp(0, cnt, 0x4E, 0xF, 0xF, true); cnt += __builtin_amdgcn_update_dpp(0, cnt, 0x141, 0xF, 0xF, true);
                if (cnt >= 13) thr = cand;
            }
            int ngt = 0, neq = 0;
#pragma unroll
            for (int i = 0; i < 16; ++i) { const int j = 16 * gq + i; ngt += (u[i] > thr) ? 1 : 0; neq += (u[i] == thr && j >= 1 && j <= T - 2) ? 1 : 0; }
            ngt += __builtin_amdgcn_update_dpp(0, ngt, 0xB1, 0xF, 0xF, true); ngt += __builtin_amdgcn_update_dpp(0, ngt, 0x4E, 0xF, 0xF, true); ngt += __builtin_amdgcn_update_dpp(0, ngt, 0x141, 0xF, 0xF, true);
            int before = 0;
#pragma unroll
            for (int g2 = 0; g2 < 7; ++g2) { const int other = __shfl(neq, (lane & ~7) | g2); before += (g2 < gq) ? other : 0; }
            int need = 13 - ngt - before;
#pragma unroll
            for (int i = 0; i < 16; ++i) {
                const int j = 16 * gq + i; bool sel = u[i] > thr;
                if (u[i] == thr && j >= 1 && j <= T - 2) { sel = need > 0; --need; }
                if (j == 0 || j == T - 1 || j == T) sel = true;
                m16 |= sel ? (1u << i) : 0u;
            }
        }
        const unsigned hi = (unsigned)__builtin_amdgcn_update_dpp(0, (int)m16, 0xB1, 0xF, 0xF, true);
        if ((gq & 1) == 0) selm[qi * 4 + (gq >> 1)] = m16 | (hi << 16);
    }
    __syncthreads();
#pragma unroll
    for (int cg_ = 0; cg_ < 2; ++cg_) { const float gsc = GATE(0, cg_);
#pragma unroll
        for (int df = 0; df < 4; ++df) stash[(cg_ * 4 + df) * 512 + tid] = oc[cg_][df] * gsc; }
    unsigned long long sw[2][2];
#pragma unroll
    for (int cg_ = 0; cg_ < 2; ++cg_) { const unsigned* sp = selm + (8 * w + 4 * cg_ + (c >> 2)) * 4;
        sw[cg_][0] = (unsigned long long)sp[0] | ((unsigned long long)sp[1] << 32); sw[cg_][1] = (unsigned long long)sp[2] | ((unsigned long long)sp[3] << 32); }
    for (int rep_ = 0; rep_ < REP_SEL; ++rep_) {
        float m[2] = {-1e30f, -1e30f}, l[2] = {0.f, 0.f}; f32x4 o[2][4];
#pragma unroll
        for (int cg_ = 0; cg_ < 2; ++cg_)
#pragma unroll
            for (int df = 0; df < 4; ++df) o[cg_][df] = (f32x4){0.f, 0.f, 0.f, 0.f};
        band_loop<true>(lds, lds3, (const unsigned char*)a.KVS + (size_t)bg * 128 * SLOTB, T, 0, T, 1 << 30, q, tq, sw, H, farb, m, l, o, wu, soff, r, fq);
        if (rep_ == REP_SEL - 1)
#pragma unroll
        for (int cg_ = 0; cg_ < 2; ++cg_) { const float sc = GATE(1, cg_) / quad_sum(l[cg_]);
#pragma unroll
            for (int df = 0; df < 4; ++df) stash[(cg_ * 4 + df) * 512 + tid] += o[cg_][df] * sc; }
    }
    for (int rep_ = 0; rep_ < REP_WIN; ++rep_) {
        float m[2] = {-1e30f, -1e30f}, l[2] = {0.f, 0.f}; f32x4 o[2][4];
#pragma unroll
        for (int cg_ = 0; cg_ < 2; ++cg_)
#pragma unroll
            for (int df = 0; df < 4; ++df) o[cg_][df] = (f32x4){0.f, 0.f, 0.f, 0.f};
        band_loop<false>(lds, lds3, (const unsigned char*)a.KVW + (size_t)bg * 128 * SLOTB, T, T - 8 > 0 ? T - 8 : 0, T, 512, q, tq, sw, H, farb, m, l, o, wu, soff, r, fq);
        if (rep_ == REP_WIN - 1)
#pragma unroll
        for (int cg_ = 0; cg_ < 2; ++cg_) { const float sc = GATE(2, cg_) / quad_sum(l[cg_]);
            bf16_t* op = a.OA + (size_t)(b * SEQ + tq[cg_]) * 1024 + H * 64 + 8 * fq;
#pragma unroll
            for (int e = 0; e < 2; ++e) {
                const f32x4 x0 = stash[(cg_ * 4 + 2 * e) * 512 + tid] + o[cg_][2 * e] * sc, x1 = stash[(cg_ * 4 + 2 * e + 1) * 512 + tid] + o[cg_][2 * e + 1] * sc;
                u32x4 wv; wv.x = cvt_pk_bf16(x0[0], x0[1]); wv.y = cvt_pk_bf16(x0[2], x0[3]); wv.z = cvt_pk_bf16(x1[0], x1[1]); wv.w = cvt_pk_bf16(x1[2], x1[3]);
                *(u32x4*)(op + 32 * e) = wv;
            }
        }
    }
#undef GATE
}
__device__ __forceinline__ void unitB(unsigned char* lds, PG8_LAS unsigned char* lds3, const Args& a, int b, int kvh, int T) {
    int tid = threadIdx.x; asm volatile("" : "+v"(tid));
    const int w = tid >> 6, wu = __builtin_amdgcn_readfirstlane(w), lane = tid & 63, c = lane & 15, fq = lane >> 4, hl = c & 3, r = c;
    const int hb = 4 * kvh + hl, H = 8 + hb, t0 = T * 64, bg = b * 2 + kvh;
    const float* btab = (const float*)(lds + OFF_BT);
    int tq[2]; bf16x8 q[2][2]; unsigned long long sw[2][2];
#pragma unroll
    for (int cg_ = 0; cg_ < 2; ++cg_) {
        tq[cg_] = t0 + 8 * w + 4 * cg_ + (c >> 2);
        const bf16_t* rowp = a.PQ + (size_t)(b * SEQ + tq[cg_]) * PQ_LD;
#pragma unroll
        for (int dc = 0; dc < 2; ++dc) q[cg_][dc] = *(const bf16x8*)(rowp + 1304 + hb * 64 + 32 * dc + 8 * fq);
        sw[cg_][0] = 0ull; sw[cg_][1] = 0ull;
    }
#pragma unroll
    for (int cg_ = 0; cg_ < 2; ++cg_)
#pragma unroll
        for (int dc = 0; dc < 2; ++dc) asm volatile("" : "+v"(q[cg_][dc]));
    const float farb = btab[128 * 16 + H];
    const unsigned soff = src_off(w, lane, 128);
    float m[2] = {-1e30f, -1e30f}, l[2] = {0.f, 0.f}; f32x4 o[2][4];
#pragma unroll
    for (int cg_ = 0; cg_ < 2; ++cg_)
#pragma unroll
        for (int df = 0; df < 4; ++df) o[cg_][df] = (f32x4){0.f, 0.f, 0.f, 0.f};
    band_loop<false>(lds, lds3, (const unsigned char*)a.KVB + (size_t)bg * 128 * SLOTB, T, T - 2 > 0 ? T - 2 : 0, T, 128, q, tq, sw, H, farb, m, l, o, wu, soff, r, fq);
    const float sink2 = a.sinks[hb] * LOG2E;
#pragma unroll
    for (int cg_ = 0; cg_ < 2; ++cg_) {
        const float lt = quad_sum(l[cg_]) + __builtin_amdgcn_exp2f(sink2 - m[cg_]); const float sc = 1.0f / lt;
        bf16_t* op = a.OB + (size_t)(b * SEQ + tq[cg_]) * 1024 + hb * 64 + 8 * fq;
#pragma unroll
        for (int e = 0; e < 2; ++e) {
            u32x4 wv; wv.x = cvt_pk_bf16(o[cg_][2 * e][0] * sc, o[cg_][2 * e][1] * sc); wv.y = cvt_pk_bf16(o[cg_][2 * e][2] * sc, o[cg_][2 * e][3] * sc);
            wv.z = cvt_pk_bf16(o[cg_][2 * e + 1][0] * sc, o[cg_][2 * e + 1][1] * sc); wv.w = cvt_pk_bf16(o[cg_][2 * e + 1][2] * sc, o[cg_][2 * e + 1][3] * sc);
            *(u32x4*)(op + 32 * e) = wv;
        }
    }
}
}

#define LAS __attribute__((address_space(3)))
#define XB_TMO      128
#define XB_XCNT(j)  (256  + 64 * (j))
#define XB_XSUB(j)  (1280 + 64 * (j))
#define XB_XGEN(j)  (2304 + 64 * (j))
#define XB_TOP      3328
#define XB_TOPGEN   3392
#define XCD_BAR_WORDS 3456
#define XB_SPIN_CAP (1u << 18)

__device__ __forceinline__ unsigned xb_ld(unsigned* p)              { return __hip_atomic_load(p, __ATOMIC_RELAXED, __HIP_MEMORY_SCOPE_AGENT); }
__device__ __forceinline__ unsigned xb_add(unsigned* p, unsigned v) { return __hip_atomic_fetch_add(p, v, __ATOMIC_RELAXED, __HIP_MEMORY_SCOPE_AGENT); }
__device__ __forceinline__ unsigned xb_xcc_id() { return (unsigned)__builtin_amdgcn_s_getreg((3 << 11) | 20) & 0xFu; }
#define XB_SPIN(cond, bar) do { unsigned _sp = 0; while (cond) { __builtin_amdgcn_s_sleep(1); \
    if ((++_sp & 255u) == 0u) { if (xb_ld(&(bar)[XB_TMO])) break; if (_sp > XB_SPIN_CAP) { atomicAdd(&(bar)[XB_TMO], 1u); break; } } } } while (0)

struct XcdBarrier {
    unsigned* bar; unsigned x;
    volatile LAS unsigned* st;
};

__device__ __forceinline__ XcdBarrier xcd_barrier_post(unsigned* bar, volatile LAS unsigned* st) {
    XcdBarrier b; b.bar = bar; b.x = xb_xcc_id(); b.st = st;
    if (threadIdx.x == 0) (void)xb_add(&bar[XB_XCNT(b.x)], 1u);
    return b;
}
__device__ __forceinline__ void xcd_barrier_complete(unsigned* bar, unsigned x, unsigned& nloc, unsigned& nx) {
    const unsigned G = gridDim.x * gridDim.y * gridDim.z;
    unsigned sum, cnt, mine, sp = 0u;
    for (;;) {
        sum = 0u; cnt = 0u; mine = 0u;
#pragma unroll
        for (unsigned j = 0; j < 16; ++j) { const unsigned c = xb_ld(&bar[XB_XCNT(j)]); sum += c; cnt += (c > 0u) ? 1u : 0u; mine = (j == x) ? c : mine; }
        if (sum == G) break;
        __builtin_amdgcn_s_sleep(1);
        if ((++sp & 255u) == 0u) { if (xb_ld(&bar[XB_TMO])) break; if (sp > XB_SPIN_CAP) { atomicAdd(&bar[XB_TMO], 1u); break; } }
    }
    nloc = mine > 0u ? mine : 1u; nx = cnt > 0u ? cnt : 1u;
}

__device__ __forceinline__ void xcd_barrier(const XcdBarrier& b) {
    asm volatile("s_waitcnt vmcnt(0)" ::: "memory");
    __syncthreads();
    if (threadIdx.x == 0) {
        unsigned* bar = b.bar;
        __builtin_amdgcn_s_waitcnt(0);
        __builtin_amdgcn_fence(__ATOMIC_RELEASE, "agent");
        asm volatile("s_waitcnt vmcnt(0)" ::: "memory");
        unsigned nloc = b.st[0], nx = b.st[1];
        if (nloc == 0u) { xcd_barrier_complete(bar, b.x, nloc, nx); b.st[0] = nloc; b.st[1] = nx; }
        const unsigned old = xb_add(&bar[XB_XSUB(b.x)], 1u);
        const unsigned gen = old / nloc;
        if (old + 1u == (gen + 1u) * nloc) {
            __builtin_amdgcn_fence(__ATOMIC_RELEASE, "agent");
            asm volatile("s_waitcnt vmcnt(0)" ::: "memory");
            const unsigned og = xb_add(&bar[XB_TOP], 1u);
            const unsigned tg = og / nx;
            if (og + 1u == (tg + 1u) * nx) xb_add(&bar[XB_TOPGEN], 1u);
            else XB_SPIN(xb_ld(&bar[XB_TOPGEN]) == tg, bar);
            __builtin_amdgcn_fence(__ATOMIC_ACQUIRE, "agent");
            xb_add(&bar[XB_XGEN(b.x)], 1u);
            asm volatile("s_waitcnt vmcnt(0)" ::: "memory");
        } else {
            XB_SPIN(xb_ld(&bar[XB_XGEN(b.x)]) == gen, bar);
            __builtin_amdgcn_fence(__ATOMIC_ACQUIRE, "agent");
            asm volatile("s_waitcnt vmcnt(0)" ::: "memory");
        }
    }
    __syncthreads();
}


struct CmpOrder {
    int G, c, lda, ldb;
    __device__ bool next(int i, pg8::Unit& u) const { const int L = i * G + c; if (L >= 64) return false; u.pm = L; u.pn = 0; u.aoff = (long)L * 256 * lda; u.boff = (long)(L >> 5) * 256 * ldb; return true; }
};
struct CmpOrderA {
    int G, c;
    __device__ bool next(int i, pg8::Unit& u) const {
        const int L = i * G + c; if (L >= 64) return false;
        const int kv = L >> 5, r = L & 31, bg = r >> 1, half = r & 1, b = bg >> 1, g = bg & 1;
        u.pm = L; u.pn = 0; u.aoff = (long)(b * SEQ + 16 * 256 * half) * PQ_LD + 512 + kv * 128 + g * 64; u.boff = (long)kv * 256 * 2048; return true;
    }
};
struct MemOrder {
    int c, c0, mode;
    __device__ bool next(int i, pg8::Unit& u) const {
        if (i > 0 || c < c0 || c >= c0 + 32) return false; const int L = c - c0;
        if (mode == 0) { u.pm = L >> 2; u.pn = L & 3; } else { u.pm = L >> 3; u.pn = L & 7; }
        u.aoff = (long)u.pm * 256 * 1024; u.boff = (long)u.pn * 256 * 1024; return true;
    }
};
struct XOrder {
    int G, c, mode;
    __device__ bool next(int i, pg8::Unit& u) const {
        const int L = i * G + c; if (L >= 1024) return false;
        const int h = L & 3, pm = L >> 2, b = pm >> 5;
        u.pm = pm; u.pn = h; u.aoff = (long)pm * 256 * 1024 + h * 256;
        u.boff = mode == 0 ? (long)(b * 256) * 1024 + h * 256 : (long)(h * 256) * 2048 + b * 256;
        if (mode == 2) { u.aoff = (long)pm * 256 * 1024; u.boff = (long)h * 256 * 1024; }
        return true;
    }
};

__global__ void __launch_bounds__(512, 2) fwd_megakernel(Params p) {
    extern __shared__ __attribute__((aligned(16))) unsigned char lds[];
    cg::grid_group grid = cg::this_grid();
    PG8_LAS unsigned char* lds3 = (PG8_LAS unsigned char*)lds;
    const int wave = __builtin_amdgcn_readfirstlane(threadIdx.x >> 6), G = gridDim.x, bid = blockIdx.x;
    const int gw = bid * 8 + wave, NGW = G * 8;
#define GSYNC() xcd_barrier(xbar)
#define LOCAL_TID int tid = threadIdx.x; asm volatile("" : "+v"(tid)); const int lane = tid & 63; (void)lane;
    unsigned char* ws = p.ws; unsigned char* dob = (unsigned char*)p.out;
    float* CBP = (float*)(ws + WS_CB); float* CB = CBP + 2 * 16 * 256;
    float* Lacc = (float*)(ws + WS_LP); float* SS = (float*)(ws + WS_SS);
    bf16_t* W1GU = (bf16_t*)(ws + WS_W1GU); bf16_t* W1D = (bf16_t*)(ws + WS_W1D); bf16_t* W2GU = (bf16_t*)(ws + WS_W2GU); bf16_t* W2D = (bf16_t*)(ws + WS_W2D);
    bf16_t* WIN = (bf16_t*)(ws + WS_WIN); bf16_t* WC1 = (bf16_t*)(ws + WS_WC1); bf16_t* WC2 = (bf16_t*)(ws + WS_WC2);
    bf16_t* WUA = (bf16_t*)(ws + WS_WUA); bf16_t* WUB = (bf16_t*)(ws + WS_WUB); bf16_t* WOUT = (bf16_t*)(ws + WS_WOUT);
    bf16_t* WXQ = (bf16_t*)(ws + WS_WXQ); bf16_t* WXKV = (bf16_t*)(ws + WS_WXKV); bf16_t* WXO = (bf16_t*)(ws + WS_WXO);
    bf16_t* XN = (bf16_t*)(ws + WS_XN); bf16_t* OA = (bf16_t*)(ws + WS_OA); bf16_t* OB = OA + 512;
    bf16_t* Hb = (bf16_t*)(ws + WS_H); bf16_t* PQ = (bf16_t*)(ws + WS_PQ); bf16_t* PG = (bf16_t*)(ws + WS_PG); bf16_t* MERGED = (bf16_t*)(ws + WS_MERGED);
    bf16_t* QX = (bf16_t*)(ws + WS_QX); bf16_t* PX = (bf16_t*)(ws + WS_PX); bf16_t* OX = (bf16_t*)(ws + WS_OX);
    bf16_t* MEMN = (bf16_t*)(ws + WS_MEMN); bf16_t* KM = (bf16_t*)(ws + WS_KM); bf16_t* VMT = (bf16_t*)(ws + WS_VMT);
    bf16_t* ACMP = (bf16_t*)(dob + DO_ACMP); bf16_t* HC = (bf16_t*)(dob + DO_HC); bf16_t* KC = (bf16_t*)(dob + DO_KC); bf16_t* VCT = (bf16_t*)(dob + DO_VCT);
    bf16_t* KVS = (bf16_t*)(dob + DO_KVS); bf16_t* KVW = (bf16_t*)(dob + DO_KVW); bf16_t* KVB = (bf16_t*)(dob + DO_KVB); float* Tb = (float*)(dob + DO_T);

    {
        LOCAL_TID
        float* scr = (float*)(lds + wave * 16384);
#define CONVX(idx, K_, N_, dst, ldd, kofs, kind, roff, gptr) for (int it = gw; it < ((K_) / 64) * (((N_) + 31) / 32); it += NGW) conv_item(p.in[idx], K_, N_, dst, ldd, kofs, kind, roff, gptr, scr, it, lane)
#define CONVG(idx, K_, N_, dst, kind, roff, gptr) CONVX(idx, K_, N_, dst, K_, 0, kind, roff, gptr)
#define CONV(idx, K_, N_, dst, kind, roff) CONVG(idx, K_, N_, dst, kind, roff, nullptr)
        CONV(3, 1024, 2816, W1GU, 1, 0); CONV(4, 1024, 2816, W1GU, 2, 0); CONV(5, 2816, 1024, W1D, 0, 0);
        CONVG(25, 1024, 2816, W2GU, 1, 0, p.in[24]); CONVG(26, 1024, 2816, W2GU, 2, 0, p.in[24]); CONV(27, 2816, 1024, W2D, 0, 0);
        CONVG(7, 1024, 4120, WIN, 3, 0, p.in[6]);
        CONV(9, 2048, 256, WC1, 0, 0); CONV(12, 2048, 256, WC1, 0, 256);
        CONV(10, 256, 64, WC2, 0, 0); CONV(13, 256, 64, WC2, 0, 256);
        CONVX(16, 512, 1024, WUA, 1024, 0, 0, 0, nullptr); CONVX(17, 512, 1024, WUA, 1024, 512, 0, 0, nullptr);   CONV(18, 1024, 1024, WOUT, 0, 0);
        CONVG(21, 1024, 1024, WXQ, 4, 0, p.in[19]); CONV(22, 1024, 2048, WXKV, 0, 0); CONV(23, 1024, 1024, WXO, 0, 0);
#undef CONV
#undef CONVG
#undef CONVX
        const int gt = bid * 512 + tid, GT = G * 512;
        for (int i = gt; i < 232 * 1024 / 8; i += GT) *((u32x4*)(WIN + (size_t)2072 * 1024) + i) = (u32x4){0u, 0u, 0u, 0u};
        for (int i = gt; i < 192 * 256 / 8; i += GT) { *((u32x4*)(WC2 + 64 * 256) + i) = (u32x4){0u, 0u, 0u, 0u}; *((u32x4*)(WC2 + 320 * 256) + i) = (u32x4){0u, 0u, 0u, 0u}; }
        rms_pass(p.in[0], p.in[2], XN, nullptr, M, gw, NGW);
        rms_pass(p.in[1], p.in[20], MEMN, nullptr, 2048, gw, NGW);
        for (int t = gw; t < 128; t += NGW) {
            const int kv = t >> 6, kc = (t >> 2) & 15, c = (t & 3) * 64 + lane; const float* pe = p.in[kv ? 11 : 8] + kc * 128; const float* w1 = p.in[kv ? 12 : 9] + (size_t)kc * 128 * 256 + c;
            float a0 = 0.f, a1 = 0.f, a2 = 0.f, a3 = 0.f;
            for (int k = 0; k < 128; k += 4) { a0 += pe[k] * w1[(size_t)k * 256]; a1 += pe[k + 1] * w1[(size_t)(k + 1) * 256]; a2 += pe[k + 2] * w1[(size_t)(k + 2) * 256]; a3 += pe[k + 3] * w1[(size_t)(k + 3) * 256]; }
            CBP[(kv * 16 + kc) * 256 + c] = (a0 + a1) + (a2 + a3);
        }
        if (bid == 0) for (int i = tid; i < (int)(BAR_BYTES / 4); i += 512) ((unsigned*)p.ws)[i] = 0u;
    }
    grid.sync();
    { volatile LAS unsigned* st = (volatile LAS unsigned*)(lds3 + BAR_LDS_OFF); if (threadIdx.x < 2) st[threadIdx.x] = 0u; __syncthreads(); }
    const XcdBarrier xbar = xcd_barrier_post((unsigned*)p.ws, (volatile LAS unsigned*)(lds3 + BAR_LDS_OFF));
    { const int gt = bid * 512 + (int)threadIdx.x; if (gt < 512) { float t = 0.f; for (int kc = 0; kc < 16; ++kc) t += CBP[((gt >> 8) * 16 + kc) * 256 + (gt & 255)]; CB[gt] = t; } }
    { pg8::Gemm g{XN, W1GU, 1024, 1024, 1024}; pg8::StaticOrder S; S.init(M, 5632, 1024, 1024, G, bid); pg8::EpiSwiglu E{Hb, DFF, nullptr}; pg8::gemm_phase(lds3, g, S, E); }
    GSYNC();
    { pg8::Gemm g{Hb, W1D, DFF, DFF, DFF}; pg8::StaticOrder S; S.init(M, 1024, DFF, DFF, G, bid); pg8::EpiResid E{p.in[0], XN, SS, 0.5f}; pg8::gemm_phase(lds3, g, S, E); }
    GSYNC();
    { pg8::Gemm g{XN, WIN, 1024, 1024, 1024}; pg8::StaticOrder S; S.init(M, 4352, 1024, 1024, G, bid); pg8::EpiBf16 E{PQ, PQ_LD, 9, PG, PG_LD, 0, 1, nullptr, SS, nullptr}; pg8::gemm_phase(lds3, g, S, E); }
    GSYNC();
    { pg8::Gemm g{PQ, WC1, 16 * PQ_LD, 2048, 2048, PQ_LD * 2}; CmpOrderA S{G, bid}; pg8::EpiBf16 E{HC, 256, 1 << 30, nullptr, 0, 2, 0, nullptr, nullptr, CB}; pg8::gemm_phase(lds3, g, S, E); }
    { pg8::Gemm g{MEMN, WXKV, 1024, 1024, 1024}; MemOrder S{bid, G >= 128 ? 64 : 0, 0}; pg8::EpiBf16 E{KM, 1024, 1 << 30, nullptr, 0, 0, 0, nullptr, nullptr, nullptr}; pg8::gemm_phase(lds3, g, S, E); }
    if (G < 128 || bid >= 64) {
        LOCAL_TID
        const int cb0 = G < 128 ? bid : bid - 64, cG = G < 128 ? G : G - 64;
        bf16_t* tile = (bf16_t*)lds;
        for (int it0 = cb0; it0 < 3 * 16 * 128; it0 += 2 * cG) {
            const int row = tid >> 3, ch = tid & 7;
            const bool two = (it0 + cG) < 3 * 16 * 128;
            u32x4 kx[2], vx[2]; bf16_t* blk[2];
#pragma unroll
            for (int z = 0; z < 2; ++z) {
                const int it = (z == 0 || two) ? it0 + z * cG : it0;
                const int tb = it & 127, bg = (it >> 7) & 15, x = it >> 11, b = bg >> 1, g = bg & 1;
                const int kcol = (x == 0 ? 768 : (x == 1 ? 1024 : 1816)) + g * 64, vcol = (x == 0 ? 896 : (x == 1 ? 1152 : 1944)) + g * 64;
                blk[z] = (x == 0 ? KVS : (x == 1 ? KVW : KVB)) + (size_t)(bg * 128 + tb) * 8192;
                const bf16_t* src = PQ + (size_t)(b * SEQ + tb * 64 + row) * PQ_LD;
                kx[z] = *(const u32x4*)(src + kcol + ch * 8); vx[z] = *(const u32x4*)(src + vcol + ch * 8);
            }
            __syncthreads();
#pragma unroll
            for (int z = 0; z < 2; ++z) { if (z == 0 || two) *(u32x4*)(blk[z] + row * 64 + ch * 8) = kx[z]; *(u32x4*)(tile + z * 64 * 72 + row * 72 + ch * 8) = vx[z]; }
            __syncthreads();
#pragma unroll
            for (int z = 0; z < 2; ++z) {
                unsigned short e[8];
#pragma unroll
                for (int k = 0; k < 8; ++k) e[k] = tile[z * 64 * 72 + (ch * 8 + k) * 72 + row];
                u32x4 o; o.x = e[0] | ((unsigned)e[1] << 16); o.y = e[2] | ((unsigned)e[3] << 16); o.z = e[4] | ((unsigned)e[5] << 16); o.w = e[6] | ((unsigned)e[7] << 16);
                if (z == 0 || two) *(u32x4*)(blk[z] + 4096 + row * 64 + ch * 8) = o;
            }
        }
        __syncthreads();
    }
    { pg8::Gemm g{WXKV + (size_t)1024 * 1024, MEMN, 1024, 1024, 1024}; MemOrder S{bid, G >= 128 ? 96 : 0, 1}; pg8::EpiBf16 E{VMT, 2048, 1 << 30, nullptr, 0, 0, 0, nullptr, nullptr, nullptr}; pg8::gemm_phase(lds3, g, S, E); }
    GSYNC();
    { pg8::Gemm g{HC, WC2, 256, 256, 256}; CmpOrder S{G, bid, 256, 256}; pg8::EpiCmp2 E{KC, VCT}; pg8::gemm_phase(lds3, g, S, E); }
    GSYNC();
    {
        LOCAL_TID
        float* btab = (float*)(lds + att::OFF_BT);
        __syncthreads();
        for (int i = tid; i < 129 * 16; i += 512) { const int d = i >> 4, hh = i & 15; const int bk = d < 128 ? BUCKET_TAB[d] : 31; btab[i] = p.in[15][bk * 16 + hh] * LOG2E; }
        __syncthreads();
        att::Args a{PQ, KC, VCT, KVS, KVW, KVB, OA, OB, p.in[14]};
        const bool xo = (G == 256); const int nun = xo ? 8 : (2048 - bid + G - 1) / G;
        for (int i = 0; i < 2 * nun; ++i) {
            const int iu = i < nun ? i : i - nun; int bg, T;
            if (xo) { const int x = bid & 7, wi = bid >> 3, ii = iu & 3; bg = (iu < 4) ? x : x + 8; T = ii == 0 ? wi : (ii == 1 ? 63 - wi : (ii == 2 ? 64 + wi : 127 - wi)); }
            else { const int idx = bid + iu * G, tt = idx >> 4, i2 = tt >> 4, k = tt & 15; bg = idx & 15; T = (i2 & 1) ? (16 * i2 + 15 - k) : (16 * i2 + k); }
            if (i < nun) att::unitA(lds, lds3, a, bg >> 1, bg & 1, T); else att::unitB(lds, lds3, a, bg >> 1, bg & 1, T);
        }
        __syncthreads();
    }
    GSYNC();
    { pg8::Gemm g{OA, WUA, 1024, 1024, 1024}; pg8::StaticOrder S; S.init(M, 1024, 1024, 1024, G, bid); pg8::EpiGate E{PG, PG_LD, MERGED}; pg8::gemm_phase(lds3, g, S, E); }
    GSYNC();
    { pg8::Gemm g{MERGED, WOUT, 1024, 1024, 1024}; pg8::StaticOrder S; S.init(M, 1024, 1024, 1024, G, bid); pg8::EpiResid E{nullptr, XN, SS + (size_t)16 * M, 1.0f}; pg8::gemm_phase(lds3, g, S, E); }
    GSYNC();
    { pg8::Gemm g{XN, WXQ, 1024, 1024, 1024}; XOrder S{G, bid, 2}; pg8::EpiBf16 E{QX, 1024, 1 << 30, nullptr, 0, 0, 0, nullptr, SS + (size_t)16 * M, nullptr}; pg8::gemm_phase(lds3, g, S, E); }
    GSYNC();
    { pg8::Gemm g{QX, KM, 1024, 1024, 256}; XOrder S{G, bid, 0}; pg8::EpiXS E{PX, Lacc}; pg8::gemm_phase(lds3, g, S, E); }
    GSYNC();
    { pg8::Gemm g{PX, VMT, 1024, 2048, 256}; XOrder S{G, bid, 1}; pg8::EpiBf16 E{OX, 1024, 1 << 30, nullptr, 0, 0, 0, Lacc, nullptr, nullptr}; pg8::gemm_phase(lds3, g, S, E); }
    GSYNC();
    { pg8::Gemm g{OX, WXO, 1024, 1024, 1024}; pg8::StaticOrder S; S.init(M, 1024, 1024, 1024, G, bid); pg8::EpiResid E{nullptr, XN, SS + (size_t)32 * M, 1.0f}; pg8::gemm_phase(lds3, g, S, E); }
    GSYNC();
    { pg8::Gemm g{XN, W2GU, 1024, 1024, 1024}; pg8::StaticOrder S; S.init(M, 5632, 1024, 1024, G, bid); pg8::EpiSwiglu E{Hb, DFF, SS + (size_t)32 * M}; pg8::gemm_phase(lds3, g, S, E); }
    GSYNC();
    { pg8::Gemm g{Hb, W2D, DFF, DFF, DFF}; pg8::StaticOrder S; S.init(M, 1024, DFF, DFF, G, bid); pg8::EpiResid E{nullptr, XN, nullptr, 0.5f}; pg8::gemm_phase(lds3, g, S, E); }
    GSYNC();
    rms_final(XN, p.in[28], p.out, M, gw, NGW);
}

extern "C" void kernel_launch(void* const* d_in, const int* in_sizes, int n_in, void* d_out, int out_size, void* d_ws, size_t ws_size, hipStream_t stream) {
    static int grid = 0; constexpr int LDS_BYTES = 147456;
    if (grid == 0) {
        if (n_in != 29 || out_size != M * DM || ws_size < WS_END) { fprintf(stderr, "kernel_launch: unexpected shapes (n_in %d out %d ws %zu)\n", n_in, out_size, ws_size); grid = -1; return; }
        int dev = 0, cus = 0, per_cu = 0;
        (void)hipGetDevice(&dev); (void)hipDeviceGetAttribute(&cus, hipDeviceAttributeMultiprocessorCount, dev);
        (void)hipFuncSetAttribute((const void*)fwd_megakernel, hipFuncAttributeMaxDynamicSharedMemorySize, LDS_BYTES);
        (void)hipOccupancyMaxActiveBlocksPerMultiprocessor(&per_cu, (const void*)fwd_megakernel, 512, LDS_BYTES);
        if (per_cu < 1) fprintf(stderr, "kernel_launch: occupancy query says %d blocks per CU\n", per_cu);
        (void)hipGetLastError();
        grid = cus > 0 ? cus : 256;
    }
    if (grid < 0) return;
    Params p{};
    for (int i = 0; i < 29; ++i) p.in[i] = (const float*)d_in[i];
    p.out = (float*)d_out; p.ws = (unsigned char*)d_ws;
    void* args[] = {&p};
    hipError_t e = hipLaunchCooperativeKernel((const void*)fwd_megakernel, dim3(grid), dim3(512), args, LDS_BYTES, stream);
    if (e != hipSuccess) fprintf(stderr, "cooperative launch failed: %s (grid %d)\n", hipGetErrorString(e), grid);
}
```

```cpp
#include <hip/hip_runtime.h>
#include <hip/hip_cooperative_groups.h>
#include <cstdio>
#include <cstdint>
namespace cg = cooperative_groups;

namespace pg8 {
#define PG8_LAS __attribute__((address_space(3)))
typedef unsigned short bf16_t;
typedef short bf16x8 __attribute__((ext_vector_type(8)));
typedef float f32x4 __attribute__((ext_vector_type(4)));
typedef unsigned u32x4 __attribute__((ext_vector_type(4)));
typedef unsigned u32x2 __attribute__((ext_vector_type(2)));
constexpr int BM = 256, BK = 64, HALF = 128, HTB = HALF * BK * 2, STAGE_BYTES = 8 * HTB, NXCD = 8, WGM = 8;

__host__ __device__ __forceinline__ int lds_byte(int r, int c) { const int st = (r >> 4) * 2 + (c >> 5), rr = r & 15, cc = c & 31, ob = rr * 64 + cc * 2; return st * 1024 + (ob ^ (((ob >> 9) & 1) << 5)); }
__host__ __device__ __forceinline__ void stage_rc(int b, int& R, int& C) { const int st = b / 1024, sb = b % 1024, swz = sb ^ (((sb >> 9) & 1) << 5); R = (st >> 1) * 16 + swz / 64; C = (st & 1) * 32 + (swz % 64) / 2; }
__host__ __device__ __forceinline__ int perm32(int rho) { const int n = rho >> 4, i = rho & 15; return 8 * (i >> 2) + 4 * n + (i & 3); }

struct Unit { int pm, pn; long aoff, boff; };
struct Gemm { const bf16_t* A; const bf16_t* Bt; int lda, ldb, K; int ksa = 128; };

struct StaticOrder {
    int nM, nN, nwg, G, c, lda, ldb;
    __device__ void init(int M, int N, int lda_, int ldb_, int G_, int c_) { nM = M / BM; nN = N / BM; nwg = nM * nN; G = G_; c = c_; lda = lda_; ldb = ldb_; }
    __device__ bool next(int i, Unit& u) const {
        const long L = (long)i * G + c; if (L >= nwg) return false;
        int wgid = (int)L; { const int q = nwg / NXCD, r = nwg % NXCD, xcd = wgid % NXCD, off = wgid / NXCD; wgid = (xcd < r ? xcd * (q + 1) : r * (q + 1) + (xcd - r) * q) + off; }
        const int nig = WGM * nN, gid = wgid / nig, fm = gid * WGM, gsz = (nM - fm) < WGM ? (nM - fm) : WGM;
        u.pm = fm + ((wgid % nig) % gsz); u.pn = (wgid % nig) / gsz;
        u.aoff = (long)u.pm * BM * lda; u.boff = (long)u.pn * BM * ldb; return true;
    }
};

__device__ __forceinline__ unsigned cvt_pk_bf16(float lo, float hi) { unsigned r; asm volatile("v_cvt_pk_bf16_f32 %0, %1, %2" : "=v"(r) : "v"(lo), "v"(hi)); return r; }
__device__ __forceinline__ float bf2f(unsigned short v) { return __uint_as_float(((unsigned)v) << 16); }
__device__ __forceinline__ float fsigmoid(float x) { return __builtin_amdgcn_rcpf(1.0f + __builtin_amdgcn_exp2f(-1.4426950408889634f * x)); }


__device__ __forceinline__ float row_rstd(const float* ssp, int row) {
    const f32x4* p4 = (const f32x4*)(ssp + (size_t)row * 16); const f32x4 a = p4[0], b = p4[1], c = p4[2], d = p4[3];
    const float t = (((a[0] + a[1]) + (a[2] + a[3])) + ((b[0] + b[1]) + (b[2] + b[3]))) + (((c[0] + c[1]) + (c[2] + c[3])) + ((d[0] + d[1]) + (d[2] + d[3])));
    return __builtin_amdgcn_rsqf(t * (1.f / 1024.f) + 1e-6f);
}
struct EpiSwiglu {
    static constexpr bool PERM = true;
    bf16_t* H; int ldh; const float* ss;
    __device__ __forceinline__ void operator()(const f32x4 (&acc)[2][2][4][2], const Unit& u, int wr, int wc, int fr, int fq) const {
        const int row0 = u.pm * BM + wr * 64 + fr, col0 = u.pn * 128 + wc * 32 + 8 * fq;
#pragma unroll
        for (int ai = 0; ai < 2; ++ai) {
            float rsv[4];
#pragma unroll
            for (int m = 0; m < 4; ++m) rsv[m] = ss ? row_rstd(ss, row0 + ai * HALF + m * 16) : 1.0f;
#pragma unroll
            for (int m = 0; m < 4; ++m) {
                bf16_t* p = H + (size_t)(row0 + ai * HALF + m * 16) * ldh + col0;
                const float rs = rsv[m];
                float h[8];
#pragma unroll
                for (int n = 0; n < 2; ++n)
#pragma unroll
                    for (int e = 0; e < 4; ++e) { const float gv = acc[ai][0][m][n][e] * rs, uv = acc[ai][1][m][n][e] * rs; h[n * 4 + e] = gv * fsigmoid(gv) * uv; }
                u32x4 w; w.x = cvt_pk_bf16(h[0], h[1]); w.y = cvt_pk_bf16(h[2], h[3]); w.z = cvt_pk_bf16(h[4], h[5]); w.w = cvt_pk_bf16(h[6], h[7]);
                *(u32x4*)p = w;
            }
        }
    }
};
struct EpiResid {
    static constexpr bool PERM = true;
    const float* basef; bf16_t* xs; float* ss; float alpha;
    __device__ __forceinline__ void operator()(const f32x4 (&acc)[2][2][4][2], const Unit& u, int wr, int wc, int fr, int fq) const {
        const int col0 = u.pn * BM + wc * 32 + 8 * fq;
#pragma unroll
        for (int ai = 0; ai < 2; ++ai)
#pragma unroll
        for (int mh = 0; mh < 2; ++mh) {
            f32x4 bf[2][2][2]; u32x4 bh[2][2];
#pragma unroll
            for (int m2 = 0; m2 < 2; ++m2)
#pragma unroll
                for (int bj = 0; bj < 2; ++bj) {
                    const size_t off = (size_t)(u.pm * BM + ai * HALF + wr * 64 + (2 * mh + m2) * 16 + fr) * 1024 + col0 + bj * HALF;
                    if (!basef) bh[m2][bj] = *(const u32x4*)(xs + off);
                }
#pragma unroll
            for (int m2 = 0; m2 < 2; ++m2) {
                const int m = 2 * mh + m2;
                const int row = u.pm * BM + ai * HALF + wr * 64 + m * 16 + fr; float sq = 0.f;
                if (basef) {
#pragma unroll
                    for (int bj = 0; bj < 2; ++bj) { const size_t off = (size_t)row * 1024 + col0 + bj * HALF; bf[m2][bj][0] = *(const f32x4*)(basef + off); bf[m2][bj][1] = *(const f32x4*)(basef + off + 4); }
                }
#pragma unroll
                for (int bj = 0; bj < 2; ++bj) {
                    const size_t off = (size_t)row * 1024 + col0 + bj * HALF;
                    float bv[8];
                    if (basef) { const f32x4 b0 = bf[m2][bj][0], b1 = bf[m2][bj][1]; bv[0] = b0[0]; bv[1] = b0[1]; bv[2] = b0[2]; bv[3] = b0[3]; bv[4] = b1[0]; bv[5] = b1[1]; bv[6] = b1[2]; bv[7] = b1[3]; }
                    else { const u32x4 gw = bh[m2][bj];
                        bv[0] = __uint_as_float(gw.x << 16); bv[1] = __uint_as_float(gw.x & 0xffff0000u); bv[2] = __uint_as_float(gw.y << 16); bv[3] = __uint_as_float(gw.y & 0xffff0000u);
                        bv[4] = __uint_as_float(gw.z << 16); bv[5] = __uint_as_float(gw.z & 0xffff0000u); bv[6] = __uint_as_float(gw.w << 16); bv[7] = __uint_as_float(gw.w & 0xffff0000u); }
                    float y[8];
#pragma unroll
                    for (int e = 0; e < 4; ++e) { y[e] = bv[e] + alpha * acc[ai][bj][m][0][e]; y[4 + e] = bv[4 + e] + alpha * acc[ai][bj][m][1][e]; }
                    u32x4 w; w.x = cvt_pk_bf16(y[0], y[1]); w.y = cvt_pk_bf16(y[2], y[3]); w.z = cvt_pk_bf16(y[4], y[5]); w.w = cvt_pk_bf16(y[6], y[7]);
                    *(u32x4*)(xs + off) = w;
                    if (ss) sq += ((y[0] * y[0] + y[1] * y[1]) + (y[2] * y[2] + y[3] * y[3])) + ((y[4] * y[4] + y[5] * y[5]) + (y[6] * y[6] + y[7] * y[7]));
                }
                if (ss) { sq += __shfl_xor(sq, 16); sq += __shfl_xor(sq, 32); if (fq == 0) ss[(size_t)row * 16 + u.pn * 4 + wc] = sq; }
            }
        }
    }
};
struct EpiBf16 {
    static constexpr bool PERM = true;
    bf16_t* O0; int ld0; int split_pn; bf16_t* O1; int ld1; int act0, act1; const float* rowscale; const float* ss; const float* cbias;
    __device__ __forceinline__ void operator()(const f32x4 (&acc)[2][2][4][2], const Unit& u, int wr, int wc, int fr, int fq) const {
        bf16_t* O = O0; int ld = ld0, colt = u.pn * BM, act = act0;
        if (u.pn >= split_pn) { O = O1; ld = ld1; colt = (u.pn - split_pn) * BM; act = act1; }
        const int row0 = u.pm * BM + wr * 64 + fr, col0 = colt + wc * 32 + 8 * fq;
        float rsv[2][4];
#pragma unroll
        for (int ai = 0; ai < 2; ++ai)
#pragma unroll
            for (int m = 0; m < 4; ++m) {
                const int row = row0 + ai * HALF + m * 16;
                float rs = 1.0f; if (rowscale) { const f32x4 lp = *(const f32x4*)(rowscale + ((size_t)row * 4 + u.pn) * 4); rs = __builtin_amdgcn_rcpf((lp[0] + lp[1]) + (lp[2] + lp[3])); }
                if (ss) rs = row_rstd(ss, row);
                rsv[ai][m] = rs;
            }
#pragma unroll
        for (int ai = 0; ai < 2; ++ai)
#pragma unroll
            for (int m = 0; m < 4; ++m) {
                const int row = row0 + ai * HALF + m * 16;
                const float rs = rsv[ai][m];
                bf16_t* rowp = O + (size_t)row * ld + col0;
#pragma unroll
                for (int bj = 0; bj < 2; ++bj) {
                    float h[8];
#pragma unroll
                    for (int n = 0; n < 2; ++n)
#pragma unroll
                        for (int e = 0; e < 4; ++e) {
                            float x = acc[ai][bj][m][n][e] * rs;
                            if (cbias) x += cbias[(u.pm >> 5) * 256 + (col0 - colt) + bj * HALF + n * 4 + e];
                            if (act == 1) x = fsigmoid(x);
                            else if (act == 2) { const float z = 1.5957691216057308f * (x + 0.044715f * x * x * x); x = x * fsigmoid(z); }
                            h[n * 4 + e] = x;
                        }
                    u32x4 w; w.x = cvt_pk_bf16(h[0], h[1]); w.y = cvt_pk_bf16(h[2], h[3]); w.z = cvt_pk_bf16(h[4], h[5]); w.w = cvt_pk_bf16(h[6], h[7]);
                    *(u32x4*)(rowp + bj * HALF) = w;
                }
            }
    }
};
struct EpiCmp2 {
    static constexpr bool PERM = true;
    bf16_t* KC; bf16_t* VCT;
    __device__ __forceinline__ void operator()(const f32x4 (&acc)[2][2][4][2], const Unit& u, int wr, int wc, int fr, int fq) const {
        if (wc >= 2) return;
        const int col0 = wc * 32 + 8 * fq;
#pragma unroll
        for (int ai = 0; ai < 2; ++ai)
#pragma unroll
            for (int m = 0; m < 4; ++m) {
                const int row = u.pm * BM + ai * HALF + wr * 64 + m * 16 + fr;
                if (u.pm < 32) {
                    u32x4 w; w.x = cvt_pk_bf16(acc[ai][0][m][0][0], acc[ai][0][m][0][1]); w.y = cvt_pk_bf16(acc[ai][0][m][0][2], acc[ai][0][m][0][3]);
                    w.z = cvt_pk_bf16(acc[ai][0][m][1][0], acc[ai][0][m][1][1]); w.w = cvt_pk_bf16(acc[ai][0][m][1][2], acc[ai][0][m][1][3]);
                    *(u32x4*)(KC + (size_t)row * 64 + col0) = w;
                } else {
                    const int r2 = row - 8192, bg = r2 >> 9, n = r2 & 511;
#pragma unroll
                    for (int nn = 0; nn < 2; ++nn)
#pragma unroll
                        for (int e = 0; e < 4; ++e) VCT[(size_t)(bg * 64 + col0 + nn * 4 + e) * 512 + n] = (bf16_t)(cvt_pk_bf16(acc[ai][0][m][nn][e], 0.f) & 0xffffu);
                }
            }
    }
};
__device__ __forceinline__ void unpack8(float (&gv)[8], const u32x4& gw) {
    gv[0] = __uint_as_float(gw.x << 16); gv[1] = __uint_as_float(gw.x & 0xffff0000u); gv[2] = __uint_as_float(gw.y << 16); gv[3] = __uint_as_float(gw.y & 0xffff0000u);
    gv[4] = __uint_as_float(gw.z << 16); gv[5] = __uint_as_float(gw.z & 0xffff0000u); gv[6] = __uint_as_float(gw.w << 16); gv[7] = __uint_as_float(gw.w & 0xffff0000u);
}
struct EpiGate {
    static constexpr bool PERM = true, HOOK = true;
    const bf16_t* gate; int ldg; bf16_t* MO;
    __device__ __forceinline__ void hook(f32x4 (&acc)[2][2][4][2], const Unit& u, int wr, int wc, int fr, int fq) const {
        int row0 = u.pm * BM + wr * 64 + fr, col0 = u.pn * BM + wc * 32 + 8 * fq;
        asm volatile("" : "+v"(row0), "+v"(col0));
#pragma unroll
        for (int ai = 0; ai < 2; ++ai)
#pragma unroll
            for (int mh = 0; mh < 2; ++mh) {
                u32x4 ra[2][2], rb[2][2];
#pragma unroll
                for (int m2 = 0; m2 < 2; ++m2)
#pragma unroll
                    for (int bj = 0; bj < 2; ++bj) {
                        const unsigned goff = ((unsigned)(row0 + ai * HALF + (2 * mh + m2) * 16) * (unsigned)ldg + (unsigned)(col0 + bj * HALF)) * 2u;
                        ra[m2][bj] = *(const u32x4*)((const char*)gate + goff); rb[m2][bj] = *(const u32x4*)((const char*)gate + 2048 + goff);
                    }
#pragma unroll
                for (int m2 = 0; m2 < 2; ++m2)
#pragma unroll
                    for (int bj = 0; bj < 2; ++bj) {
                        const int m = 2 * mh + m2; float ga[8], gb[8]; unpack8(ga, ra[m2][bj]); unpack8(gb, rb[m2][bj]);
#pragma unroll
                        for (int e = 0; e < 4; ++e) { acc[ai][bj][m][0][e] *= ga[e] * __builtin_amdgcn_rcpf(gb[e]); acc[ai][bj][m][1][e] *= ga[4 + e] * __builtin_amdgcn_rcpf(gb[4 + e]); }
                    }
                asm volatile("" ::: "memory");
            }
    }
    __device__ __forceinline__ void operator()(const f32x4 (&acc)[2][2][4][2], const Unit& u, int wr, int wc, int fr, int fq) const {
        const int row0 = u.pm * BM + wr * 64 + fr, col0 = u.pn * BM + wc * 32 + 8 * fq;
#pragma unroll
        for (int ai = 0; ai < 2; ++ai) {
            u32x4 rb[4][2];
#pragma unroll
            for (int m = 0; m < 4; ++m)
#pragma unroll
                for (int bj = 0; bj < 2; ++bj) rb[m][bj] = *(const u32x4*)((const char*)gate + 2048 + ((unsigned)(row0 + ai * HALF + m * 16) * (unsigned)ldg + (unsigned)(col0 + bj * HALF)) * 2u);
#pragma unroll
            for (int m = 0; m < 4; ++m)
#pragma unroll
                for (int bj = 0; bj < 2; ++bj) {
                    const int row = row0 + ai * HALF + m * 16, col = col0 + bj * HALF;
                    float gb[8]; unpack8(gb, rb[m][bj]);
                    const f32x4 a0 = acc[ai][bj][m][0], a1 = acc[ai][bj][m][1];
                    u32x4 w; w.x = cvt_pk_bf16(a0[0] * gb[0], a0[1] * gb[1]); w.y = cvt_pk_bf16(a0[2] * gb[2], a0[3] * gb[3]); w.z = cvt_pk_bf16(a1[0] * gb[4], a1[1] * gb[5]); w.w = cvt_pk_bf16(a1[2] * gb[6], a1[3] * gb[7]);
                    *(u32x4*)(MO + (size_t)row * 1024 + col) = w;
                }
        }
    }
};
struct EpiXS {
    static constexpr bool PERM = true;
    bf16_t* P; float* L;
    __device__ __forceinline__ void operator()(const f32x4 (&acc)[2][2][4][2], const Unit& u, int wr, int wc, int fr, int fq) const {
        const int row0 = u.pm * BM + wr * 64 + fr, col0 = u.pn * BM + wc * 32 + 8 * fq;
#pragma unroll
        for (int ai = 0; ai < 2; ++ai)
#pragma unroll
            for (int m = 0; m < 4; ++m) {
                const int row = row0 + ai * HALF + m * 16; float rsum = 0.f;
#pragma unroll
                for (int bj = 0; bj < 2; ++bj) {
                    float h[8];
#pragma unroll
                    for (int n = 0; n < 2; ++n)
#pragma unroll
                        for (int e = 0; e < 4; ++e) { const float pe = __builtin_amdgcn_exp2f(fminf(acc[ai][bj][m][n][e], 100.f)); h[n * 4 + e] = pe; rsum += pe; }
                    u32x4 w; w.x = cvt_pk_bf16(h[0], h[1]); w.y = cvt_pk_bf16(h[2], h[3]); w.z = cvt_pk_bf16(h[4], h[5]); w.w = cvt_pk_bf16(h[6], h[7]);
                    *(u32x4*)(P + (size_t)row * 1024 + col0 + bj * HALF) = w;
                }
                rsum += __shfl_xor(rsum, 16); rsum += __shfl_xor(rsum, 32);
                if (fq == 0) L[((size_t)row * 4 + u.pn) * 4 + wc] = rsum;
            }
    }
};

template <class E, class = void> struct epi_has_hook { static constexpr bool value = false; };
template <class E> struct epi_has_hook<E, decltype((void)E::HOOK)> { static constexpr bool value = E::HOOK; };
template <class Epi, class Sched>
__device__ __forceinline__ void gemm_phase(PG8_LAS unsigned char* lds, const Gemm g, const Sched& S, const Epi& E) {
    int tid = threadIdx.x; asm volatile("" : "+v"(tid));
    const int wid = __builtin_amdgcn_readfirstlane(tid >> 6), lane = tid & 63, wr = wid >> 2, wc = wid & 3, fr = lane & 15, fq = lane >> 4;
    const int K = g.K, nt = K / BK;
    unsigned voffA[2], voffB[2];
#pragma unroll
    for (int i = 0; i < 2; ++i) { int R, C; stage_rc(tid * 16 + i * 8192, R, C); const int Rb = Epi::PERM ? ((R & ~31) + perm32(R & 31)) : R;
        voffA[i] = (unsigned)(R * g.lda + C) * 2u; voffB[i] = (unsigned)(Rb * g.ldb + C) * 2u; }
    const size_t kstep = (size_t)(BK * 2), kstepA = (size_t)g.ksa;
    const size_t hstepA = (size_t)HALF * g.lda * 2, hstepB = (size_t)HALF * g.ldb * 2;
    const unsigned ldsw = (unsigned)wid * 1024u;
    const int aoff = lds_byte(wr * 64 + fr, fq * 8), boff = lds_byte(wc * 32 + fr, fq * 8);
#define PG8_SA(b, h) (((b) * 2 + (h)) * HTB)
#define PG8_SB(b, h) ((4 + (b) * 2 + (h)) * HTB)
#define PG8_STAGE(bufoff, gbase, voff) do { _Pragma("unroll") for (int _i = 0; _i < 2; ++_i) \
        __builtin_amdgcn_global_load_lds((const unsigned*)((const char*)(gbase) + (voff)[_i]), (PG8_LAS unsigned*)(lds + (bufoff) + ldsw + _i * 8192), 16, 0, 0); } while (0)
#define PG8_LDA(dst, b, h) do { _Pragma("unroll") for (int m = 0; m < 4; ++m) _Pragma("unroll") for (int k = 0; k < 2; ++k) dst[m][k] = *(const PG8_LAS bf16x8*)(lds + PG8_SA(b, h) + aoff + m * 2048 + k * 1024); } while (0)
#define PG8_LDB(dst, b, h) do { _Pragma("unroll") for (int n = 0; n < 2; ++n) _Pragma("unroll") for (int k = 0; k < 2; ++k) dst[n][k] = *(const PG8_LAS bf16x8*)(lds + PG8_SB(b, h) + boff + n * 2048 + k * 1024); } while (0)
#define PG8_MMA(ai, bj, At, Bt) do { __builtin_amdgcn_s_setprio(1); _Pragma("unroll") for (int m = 0; m < 4; ++m) _Pragma("unroll") for (int n = 0; n < 2; ++n) _Pragma("unroll") for (int k = 0; k < 2; ++k) \
        acc[ai][bj][m][n] = __builtin_amdgcn_mfma_f32_16x16x32_bf16(Bt[n][k], At[m][k], acc[ai][bj][m][n], 0, 0, 0); __builtin_amdgcn_s_setprio(0); } while (0)
#define PG8_WAIT_V(n) asm volatile("s_waitcnt vmcnt(" #n ")" ::: "memory")
#define PG8_WAIT_L(n) asm volatile("s_waitcnt lgkmcnt(" #n ")" ::: "memory")
#define PG8_BAR __builtin_amdgcn_s_barrier()
#define PG8_SCHED __builtin_amdgcn_sched_barrier(0)
    Unit cur, nxt; int ui = 0;
    if (!S.next(0, cur)) return;
    f32x4 acc[2][2][4][2];
#pragma unroll
    for (int a = 0; a < 2; ++a)
#pragma unroll
        for (int b = 0; b < 2; ++b)
#pragma unroll
            for (int m = 0; m < 4; ++m)
#pragma unroll
                for (int n = 0; n < 2; ++n) acc[a][b][m][n] = (f32x4){0.f, 0.f, 0.f, 0.f};
    bf16x8 At[4][2], B0[2][2], B1[2][2];
    const char* cA = (const char*)g.A + (size_t)cur.aoff * 2; const char* cB = (const char*)g.Bt + (size_t)cur.boff * 2;
    PG8_STAGE(PG8_SB(0, 0), cB, voffB); PG8_STAGE(PG8_SB(0, 1), cB + hstepB, voffB); PG8_STAGE(PG8_SA(0, 0), cA, voffA); PG8_STAGE(PG8_SA(0, 1), cA + hstepA, voffA);
    if (wr == 1) PG8_BAR;
    PG8_WAIT_V(2); PG8_BAR;
    PG8_STAGE(PG8_SB(1, 0), cB + kstep, voffB); PG8_STAGE(PG8_SA(1, 0), cA + kstepA, voffA); PG8_STAGE(PG8_SB(1, 1), cB + hstepB + kstep, voffB);
    PG8_WAIT_V(6); PG8_BAR;
    for (;;) {
        const bool has_next = S.next(ui + 1, nxt);
        const char* nA = has_next ? (const char*)g.A + (size_t)nxt.aoff * 2 : cA; const char* nB = has_next ? (const char*)g.Bt + (size_t)nxt.boff * 2 : cB;
#pragma nounroll
        for (int t = 0; t < nt; t += 2) {
            const bool last = (t == nt - 2);
            const char* a1 = cA + (size_t)(t + 1) * kstepA;
            const char* a2 = last ? nA : cA + (size_t)(t + 2) * kstepA; const char* b2 = last ? nB : cB + (size_t)(t + 2) * kstep;
            const char* a3 = a2 + kstepA; const char* b3 = b2 + kstep;
            if constexpr (epi_has_hook<Epi>::value) { if (t == nt / 2) E.hook(acc, cur, wr, wc, fr, fq); }
            PG8_LDB(B0, 0, 0); PG8_LDB(B1, 0, 1); PG8_SCHED; PG8_LDA(At, 0, 0); PG8_STAGE(PG8_SA(1, 1), a1 + hstepA, voffA);
            PG8_WAIT_V(8); PG8_WAIT_L(0); PG8_BAR; PG8_MMA(0, 0, At, B0); PG8_MMA(0, 1, At, B1); PG8_BAR; PG8_SCHED;
            PG8_LDA(At, 0, 1); PG8_STAGE(PG8_SB(0, 0), b2, voffB); PG8_STAGE(PG8_SB(0, 1), b2 + hstepB, voffB); PG8_STAGE(PG8_SA(0, 0), a2, voffA);
            PG8_WAIT_V(8); PG8_WAIT_L(0); PG8_BAR; PG8_MMA(1, 0, At, B0); PG8_MMA(1, 1, At, B1); PG8_BAR; PG8_SCHED;
            PG8_LDB(B0, 1, 0); PG8_LDB(B1, 1, 1); PG8_SCHED; PG8_LDA(At, 1, 0); PG8_STAGE(PG8_SA(0, 1), a2 + hstepA, voffA);
            PG8_WAIT_V(8); PG8_WAIT_L(0); PG8_BAR; PG8_MMA(0, 0, At, B0); PG8_MMA(0, 1, At, B1); PG8_BAR; PG8_SCHED;
            PG8_LDA(At, 1, 1); PG8_STAGE(PG8_SB(1, 0), b3, voffB); PG8_STAGE(PG8_SB(1, 1), b3 + hstepB, voffB); PG8_STAGE(PG8_SA(1, 0), a3, voffA);
            PG8_WAIT_V(8); PG8_WAIT_L(0); PG8_BAR; PG8_MMA(1, 0, At, B0); PG8_MMA(1, 1, At, B1); PG8_BAR; PG8_SCHED;
        }
        if (wr == 0) PG8_BAR;
        E(acc, cur, wr, wc, fr, fq);
        if (!has_next) break;
#pragma unroll
        for (int a = 0; a < 2; ++a)
#pragma unroll
            for (int b = 0; b < 2; ++b)
#pragma unroll
                for (int m = 0; m < 4; ++m)
#pragma unroll
                    for (int n = 0; n < 2; ++n) acc[a][b][m][n] = (f32x4){0.f, 0.f, 0.f, 0.f};
        cur = nxt; cA = nA; cB = nB; ++ui;
        if (wr == 1) PG8_BAR;
    }
    PG8_WAIT_V(0);
    PG8_BAR;
#undef PG8_SA
#undef PG8_SB
#undef PG8_STAGE
#undef PG8_LDA
#undef PG8_LDB
#undef PG8_MMA
#undef PG8_WAIT_V
#undef PG8_WAIT_L
#undef PG8_BAR
#undef PG8_SCHED
}
}

using pg8::bf16_t; using pg8::bf16x8; using pg8::f32x4; using pg8::u32x4; using pg8::u32x2;
using pg8::cvt_pk_bf16; using pg8::bf2f; using pg8::fsigmoid;

constexpr int M = 65536, DM = 1024, DFF = 2816, SEQ = 8192;
constexpr size_t MiB = 1u << 20;
constexpr size_t WS_L = 0, WS_CB = 64 * 1024;
constexpr size_t WS_W1GU = 1 * MiB, WS_W1D = 12 * MiB, WS_W2GU = 18 * MiB, WS_W2D = 29 * MiB, WS_WIN = 35 * MiB, WS_WC1 = 44 * MiB, WS_WC2 = 46 * MiB,
                 WS_WUA = 47 * MiB, WS_WUB = 48 * MiB, WS_WOUT = 49 * MiB, WS_WXQ = 51 * MiB, WS_WXKV = 53 * MiB, WS_WXO = 57 * MiB;
constexpr size_t WS_OA = 65 * MiB, WS_XN = 321 * MiB, WS_R = 449 * MiB;
constexpr size_t WS_H = WS_R, WS_PQ = WS_R, WS_PG = 737 * MiB, WS_MERGED = WS_R, WS_QX = WS_R, WS_PX = 577 * MiB, WS_OX = 705 * MiB;
constexpr size_t WS_MEMN = 993 * MiB, WS_KM = 997 * MiB, WS_VMT = 1001 * MiB, WS_SS = 1005 * MiB, WS_LP = 1017 * MiB, WS_END = 1021 * MiB;
constexpr size_t DO_ACMP = 0, DO_HC = 64 * MiB, DO_KC = 72 * MiB, DO_VCT = 73 * MiB, DO_KVS = 80 * MiB, DO_KVW = 112 * MiB, DO_KVB = 144 * MiB, DO_T = 0;
constexpr int PQ_LD = 2304, PG_LD = 2048;
constexpr int BAR_LDS_OFF = 147456 - 16;
constexpr size_t BAR_BYTES = 16384;
constexpr float LOG2E = 1.4426950408889634f;

__device__ const unsigned char BUCKET_TAB[128] = {0, 1, 2, 3, 4, 5, 6, 7, 8, 9, 10, 11, 12, 13, 14, 15, 16, 16, 16, 17, 17, 18, 18, 18, 19, 19, 19, 20, 20, 20, 20, 21, 21, 21, 21, 22, 22, 22, 22, 22, 23, 23, 23, 23, 23, 23, 24, 24, 24, 24, 24, 24, 25, 25, 25, 25, 25, 25, 25, 26, 26, 26, 26, 26, 26, 26, 26, 27, 27, 27, 27, 27, 27, 27, 27, 27, 27, 28, 28, 28, 28, 28, 28, 28, 28, 28, 28, 29, 29, 29, 29, 29, 29, 29, 29, 29, 29, 29, 29, 30, 30, 30, 30, 30, 30, 30, 30, 30, 30, 30, 30, 30, 30, 31, 31, 31, 31, 31, 31, 31, 31, 31, 31, 31, 31, 31, 31, 31};

#define PROBE_ATT_A 1
#define REP_CMP 1
#define REP_TOPK 1
#define REP_SEL 1
#define REP_WIN 1
#define PROBE_ATT_B 1
struct Params { const float* in[29]; float* out; unsigned char* ws; };

__device__ __forceinline__ float wave_sum(float v) {
#pragma unroll
    for (int o = 1; o < 64; o <<= 1) v += __shfl_xor(v, o);
    return v;
}
__device__ __forceinline__ void conv_item(const float* W, int K, int N, bf16_t* WT, int ldd, int kofs, int kind, int roff, const float* gk, float* scr, int item, int lane) {
    const int nblk = (N + 31) / 32, kb = item / nblk, nb = item % nblk, k0 = 64 * kb, n0 = 32 * nb;
    const int nr = n0 + (lane & 31);
    float wv[32];
#pragma unroll
    for (int i = 0; i < 32; ++i) { const int kk = 2 * i + (lane >> 5); wv[i] = (nr < N) ? W[(size_t)(k0 + kk) * N + nr] : 0.f; }
#pragma unroll
    for (int i = 0; i < 32; ++i) { const int kk = 2 * i + (lane >> 5); scr[kk * 33 + (lane & 31)] = wv[i]; }
    asm volatile("s_waitcnt lgkmcnt(0)" ::: "memory");
    const int c = lane & 7;
#pragma unroll
    for (int j = 0; j < 4; ++j) {
        const int nl = (lane >> 3) + 8 * j, n = n0 + nl; const float* s = scr + (8 * c) * 33 + nl;
        int dr = n + roff; float sc = 1.0f;
        if (kind == 1) dr = (n >> 7) * 256 + (n & 127);
        else if (kind == 2) dr = (n >> 7) * 256 + 128 + (n & 127);
        else if (kind == 3) { dr = n < 2072 ? n : n + 232; if (n < 512 || (n >= 1304 && n < 1816)) sc = 0.125f * LOG2E; }
        else if (kind == 4) sc = 0.0625f * LOG2E;
        f32x4 g0 = (f32x4){sc, sc, sc, sc}, g1 = g0;
        if (gk) { g0 = *(const f32x4*)(gk + k0 + 8 * c) * sc; g1 = *(const f32x4*)(gk + k0 + 8 * c + 4) * sc; }
        u32x4 o; o.x = cvt_pk_bf16(s[0 * 33] * g0[0], s[1 * 33] * g0[1]); o.y = cvt_pk_bf16(s[2 * 33] * g0[2], s[3 * 33] * g0[3]); o.z = cvt_pk_bf16(s[4 * 33] * g1[0], s[5 * 33] * g1[1]); o.w = cvt_pk_bf16(s[6 * 33] * g1[2], s[7 * 33] * g1[3]);
        if (n < N) *(u32x4*)(WT + (size_t)dr * ldd + kofs + k0 + 8 * c) = o;
    }
    asm volatile("s_waitcnt lgkmcnt(0)" ::: "memory");
}
__device__ __forceinline__ void rms_row(const float* xrow, const float* g, bf16_t* orow, float* frow, int lane) {
    const f32x4* xr = (const f32x4*)xrow + lane; const f32x4* gr = (const f32x4*)g + lane;
    f32x4 v[4]; float s = 0.f;
#pragma unroll
    for (int j = 0; j < 4; ++j) { v[j] = xr[64 * j]; s += (v[j].x * v[j].x + v[j].y * v[j].y) + (v[j].z * v[j].z + v[j].w * v[j].w); }
    const float rstd = 1.0f / sqrtf(wave_sum(s) * (1.f / 1024.f) + 1e-6f);
#pragma unroll
    for (int j = 0; j < 4; ++j) {
        const f32x4 gg = gr[64 * j]; const f32x4 y = v[j] * rstd * gg;
        if (orow) { u32x2 w; w.x = cvt_pk_bf16(y.x, y.y); w.y = cvt_pk_bf16(y.z, y.w); *((u32x2*)orow + lane + 64 * j) = w; }
        else *((f32x4*)frow + lane + 64 * j) = y;
    }
}
__device__ __forceinline__ void rms_row_bf16(const bf16_t* xrow, const float* g, float* frow, int lane) {
    float v[2][8]; float s = 0.f;
#pragma unroll
    for (int j = 0; j < 2; ++j) { const u32x4 gw = *((const u32x4*)xrow + lane + 64 * j);
        v[j][0] = __uint_as_float(gw.x << 16); v[j][1] = __uint_as_float(gw.x & 0xffff0000u); v[j][2] = __uint_as_float(gw.y << 16); v[j][3] = __uint_as_float(gw.y & 0xffff0000u);
        v[j][4] = __uint_as_float(gw.z << 16); v[j][5] = __uint_as_float(gw.z & 0xffff0000u); v[j][6] = __uint_as_float(gw.w << 16); v[j][7] = __uint_as_float(gw.w & 0xffff0000u);
#pragma unroll
        for (int e = 0; e < 8; ++e) s += v[j][e] * v[j][e]; }
    const float rstd = 1.0f / sqrtf(wave_sum(s) * (1.f / 1024.f) + 1e-6f);
#pragma unroll
    for (int j = 0; j < 2; ++j) {
        const f32x4 g0 = *((const f32x4*)g + 2 * (lane + 64 * j)), g1 = *((const f32x4*)g + 2 * (lane + 64 * j) + 1);
        *((f32x4*)frow + 2 * (lane + 64 * j)) = (f32x4){v[j][0] * rstd * g0[0], v[j][1] * rstd * g0[1], v[j][2] * rstd * g0[2], v[j][3] * rstd * g0[3]};
        *((f32x4*)frow + 2 * (lane + 64 * j) + 1) = (f32x4){v[j][4] * rstd * g1[0], v[j][5] * rstd * g1[1], v[j][6] * rstd * g1[2], v[j][7] * rstd * g1[3]};
    }
}
__device__ __forceinline__ void rms_pass(const float* X, const float* g, bf16_t* O, float* F, int rows, int gw, int NGW) {
    int tid_ = threadIdx.x; asm volatile("" : "+v"(tid_)); const int lane = tid_ & 63;
    const f32x4* gr = (const f32x4*)g + lane;
    for (int m = gw; m < rows; m += 2 * NGW) {
        const bool two = (m + NGW) < rows; const int m1 = two ? m + NGW : m;
        const f32x4* x0 = (const f32x4*)(X + (size_t)m * 1024) + lane; const f32x4* x1 = (const f32x4*)(X + (size_t)m1 * 1024) + lane;
        f32x4 v0[4], v1[4]; float s0 = 0.f, s1 = 0.f;
#pragma unroll
        for (int j = 0; j < 4; ++j) { v0[j] = x0[64 * j]; v1[j] = x1[64 * j]; }
#pragma unroll
        for (int j = 0; j < 4; ++j) { s0 += (v0[j].x * v0[j].x + v0[j].y * v0[j].y) + (v0[j].z * v0[j].z + v0[j].w * v0[j].w); s1 += (v1[j].x * v1[j].x + v1[j].y * v1[j].y) + (v1[j].z * v1[j].z + v1[j].w * v1[j].w); }
        const float r0 = 1.0f / sqrtf(wave_sum(s0) * (1.f / 1024.f) + 1e-6f), r1 = 1.0f / sqrtf(wave_sum(s1) * (1.f / 1024.f) + 1e-6f);
#pragma unroll
        for (int j = 0; j < 4; ++j) {
            const f32x4 gg = gr[64 * j]; const f32x4 y0 = v0[j] * r0 * gg, y1 = v1[j] * r1 * gg;
            u32x2 w0, w1; w0.x = cvt_pk_bf16(y0.x, y0.y); w0.y = cvt_pk_bf16(y0.z, y0.w); w1.x = cvt_pk_bf16(y1.x, y1.y); w1.y = cvt_pk_bf16(y1.z, y1.w);
            *((u32x2*)(O + (size_t)m * 1024) + lane + 64 * j) = w0;
            if (two) *((u32x2*)(O + (size_t)m1 * 1024) + lane + 64 * j) = w1;
        }
    }
}
__device__ __forceinline__ void rms_final(const bf16_t* X, const float* g, float* out, int rows, int gw, int NGW) {
    int tid_ = threadIdx.x; asm volatile("" : "+v"(tid_)); const int lane = tid_ & 63;
    for (int m = gw; m < rows; m += 4 * NGW) {
        u32x4 raw[4][2];
#pragma unroll
        for (int k = 0; k < 4; ++k) { const int mk = (m + k * NGW) < rows ? m + k * NGW : m;
#pragma unroll
            for (int j = 0; j < 2; ++j) raw[k][j] = *((const u32x4*)(X + (size_t)mk * 1024) + lane + 64 * j); }
#pragma unroll
        for (int k = 0; k < 4; ++k) {
            float v[2][8]; float sq = 0.f;
#pragma unroll
            for (int j = 0; j < 2; ++j) { const u32x4 gw4 = raw[k][j];
                v[j][0] = __uint_as_float(gw4.x << 16); v[j][1] = __uint_as_float(gw4.x & 0xffff0000u); v[j][2] = __uint_as_float(gw4.y << 16); v[j][3] = __uint_as_float(gw4.y & 0xffff0000u);
                v[j][4] = __uint_as_float(gw4.z << 16); v[j][5] = __uint_as_float(gw4.z & 0xffff0000u); v[j][6] = __uint_as_float(gw4.w << 16); v[j][7] = __uint_as_float(gw4.w & 0xffff0000u);
#pragma unroll
                for (int e = 0; e < 8; ++e) sq += v[j][e] * v[j][e]; }
            const float rstd = 1.0f / sqrtf(wave_sum(sq) * (1.f / 1024.f) + 1e-6f);
            if ((m + k * NGW) < rows) {
                float* frow = out + (size_t)(m + k * NGW) * 1024;
#pragma unroll
                for (int j = 0; j < 2; ++j) {
                    const f32x4 g0 = *((const f32x4*)g + 2 * (lane + 64 * j)), g1 = *((const f32x4*)g + 2 * (lane + 64 * j) + 1);
                    *((f32x4*)frow + 2 * (lane + 64 * j)) = (f32x4){v[j][0] * rstd * g0[0], v[j][1] * rstd * g0[1], v[j][2] * rstd * g0[2], v[j][3] * rstd * g0[3]};
                    *((f32x4*)frow + 2 * (lane + 64 * j) + 1) = (f32x4){v[j][4] * rstd * g1[0], v[j][5] * rstd * g1[1], v[j][6] * rstd * g1[2], v[j][7] * rstd * g1[3]};
                }
            }
        }
    }
}

namespace att {
constexpr int SLOTB = 16384, NSLOT = 4;
constexpr int OFF_RING = 0, OFF_BT = NSLOT * SLOTB, OFF_SEL = OFF_BT + 129 * 16 * 4 + 192, OFF_IMP = OFF_SEL + 64 * 4 * 4, IMP_LD = 129, OFF_STASH = OFF_IMP, ATT_LDS = OFF_STASH + 32 * 512 * 4;
static_assert(OFF_IMP % 16 == 0 && 64 * IMP_LD * 4 <= 32 * 512 * 4 && ATT_LDS <= 147456, "attention LDS map");
struct Args { const bf16_t* PQ; const bf16_t* KC; const bf16_t* VCT; const bf16_t* KVS; const bf16_t* KVW; const bf16_t* KVB; bf16_t* OA; bf16_t* OB; const float* sinks; };

__device__ __forceinline__ int prow(int f, int r) { return 32 * (f >> 1) + 8 * (r >> 2) + 4 * (f & 1) + (r & 3); }
__device__ __forceinline__ int swz(int R) { return (R & 2) | ((R & 8) >> 1); }
__device__ __forceinline__ unsigned src_off(int w, int lane, int ldB) { const int R = 8 * w + (lane >> 3), cch = (lane & 7) ^ swz(R); return (unsigned)(R * ldB + cch * 16); }
__device__ __forceinline__ void glds16(const void* gsrc, unsigned lds_dst) { unsigned keep;
    asm volatile("s_mov_b32 %0, m0\n\ts_mov_b32 m0, %2\n\ts_nop 0\n\tglobal_load_lds_dwordx4 %1, off\n\ts_mov_b32 m0, %0" : "=&s"(keep) : "v"(gsrc), "s"(lds_dst) : "memory"); }
__device__ __forceinline__ void dma_block(PG8_LAS unsigned char* lds3, int slot, int wu, const unsigned char* Kblk, unsigned koff, const unsigned char* Vblk, unsigned voff) {
    const unsigned base = (unsigned)(__UINTPTR_TYPE__)lds3 + OFF_RING + slot * SLOTB + wu * 1024;
    glds16(Kblk + koff, (unsigned)__builtin_amdgcn_readfirstlane(base));
    glds16(Vblk + voff, (unsigned)__builtin_amdgcn_readfirstlane(base + 8192));
}
__device__ __forceinline__ void ring_wait_bar(int young) {
    if (young >= 2) asm volatile("s_waitcnt vmcnt(4)" ::: "memory"); else if (young == 1) asm volatile("s_waitcnt vmcnt(2)" ::: "memory"); else asm volatile("s_waitcnt vmcnt(0)" ::: "memory");
    asm volatile("s_waitcnt lgkmcnt(0)" ::: "memory");
    __builtin_amdgcn_s_barrier();
    asm volatile("" ::: "memory");
}
__device__ __forceinline__ void load_kfrags(bf16x8 (&kf)[4][2], const unsigned char* Ks, int r, int fq) {
#pragma unroll
    for (int f = 0; f < 4; ++f)
#pragma unroll
        for (int dc = 0; dc < 2; ++dc) { const int R = prow(f, r); kf[f][dc] = *(const bf16x8*)(Ks + R * 128 + (((4 * dc + fq) ^ swz(R)) << 4)); }
}
__device__ __forceinline__ void qk(f32x4 (&s)[4], const bf16x8 (&kf)[4][2], const bf16x8 (&q)[2], float cinit) {
#pragma unroll
    for (int f = 0; f < 4; ++f) {
        s[f] = (f32x4){cinit, cinit, cinit, cinit};
#pragma unroll
        for (int dc = 0; dc < 2; ++dc) s[f] = __builtin_amdgcn_mfma_f32_16x16x32_bf16(kf[f][dc], q[dc], s[f], 0, 0, 0);
    }
}
__device__ __forceinline__ void pv(f32x4 (&o)[4], const float (&p)[4][4], const unsigned char* Vs, int r, int fq) {
    bf16x8 pb[2];
#pragma unroll
    for (int kc = 0; kc < 2; ++kc) {
        u32x4 w; w.x = cvt_pk_bf16(p[2 * kc][0], p[2 * kc][1]); w.y = cvt_pk_bf16(p[2 * kc][2], p[2 * kc][3]); w.z = cvt_pk_bf16(p[2 * kc + 1][0], p[2 * kc + 1][1]); w.w = cvt_pk_bf16(p[2 * kc + 1][2], p[2 * kc + 1][3]);
        pb[kc] = __builtin_bit_cast(bf16x8, w);
    }
#pragma unroll
    for (int df = 0; df < 4; ++df)
#pragma unroll
        for (int kc = 0; kc < 2; ++kc) {
            const int R = prow(df, r);
            const bf16x8 vf = *(const bf16x8*)(Vs + R * 128 + (((4 * kc + fq) ^ swz(R)) << 4));
            o[df] = __builtin_amdgcn_mfma_f32_16x16x32_bf16(vf, pb[kc], o[df], 0, 0, 0);
        }
}
__device__ __forceinline__ void logits(float (&v)[4][4], const f32x4 (&s)[4], int tq, int kpos0, int kstride, int fq, int H, const float* btab, float farb, bool use_tab, int wl) {
#pragma unroll
    for (int f = 0; f < 4; ++f)
#pragma unroll
        for (int i = 0; i < 4; ++i) {
            const int kk = 32 * (f >> 1) + 8 * fq + 4 * (f & 1) + i;
            const int dist = tq - (kpos0 + kstride * kk);
            const bool ok = dist >= 0 && dist < wl;
            const int di = dist < 0 ? 0 : (dist > 128 ? 128 : dist);
            v[f][i] = ok ? s[f][i] + btab[di * 16 + H] : -1e30f;
        }
}
__device__ __forceinline__ float red_max4(float x) {
    auto a = __builtin_amdgcn_permlane16_swap(__float_as_uint(x), __float_as_uint(x), false, false); x = fmaxf(__uint_as_float(a[0]), __uint_as_float(a[1]));
    auto b = __builtin_amdgcn_permlane32_swap(__float_as_uint(x), __float_as_uint(x), false, false); return fmaxf(__uint_as_float(b[0]), __uint_as_float(b[1]));
}
__device__ __forceinline__ float quad_sum(float x) {
    auto a = __builtin_amdgcn_permlane16_swap(__float_as_uint(x), __float_as_uint(x), false, false); x = __uint_as_float(a[0]) + __uint_as_float(a[1]);
    auto b = __builtin_amdgcn_permlane32_swap(__float_as_uint(x), __float_as_uint(x), false, false); return __uint_as_float(b[0]) + __uint_as_float(b[1]);
}
__device__ __forceinline__ float dpp_xor1(float x) { return __builtin_bit_cast(float, __builtin_amdgcn_update_dpp(0, __builtin_bit_cast(int, x), 0xB1, 0xF, 0xF, true)); }
__device__ __forceinline__ float dpp_xor2(float x) { return __builtin_bit_cast(float, __builtin_amdgcn_update_dpp(0, __builtin_bit_cast(int, x), 0x4E, 0xF, 0xF, true)); }
__device__ __forceinline__ float max16(const float (&v)[4][4]) {
    float a = fmaxf(fmaxf(v[0][0], v[0][1]), fmaxf(v[0][2], v[0][3])), b = fmaxf(fmaxf(v[1][0], v[1][1]), fmaxf(v[1][2], v[1][3]));
    float c = fmaxf(fmaxf(v[2][0], v[2][1]), fmaxf(v[2][2], v[2][3])), d = fmaxf(fmaxf(v[3][0], v[3][1]), fmaxf(v[3][2], v[3][3]));
    return fmaxf(fmaxf(a, b), fmaxf(c, d));
}
__device__ __forceinline__ float max3f(float a, float b, float c) { float r; asm("v_max3_f32 %0, %1, %2, %3" : "=v"(r) : "v"(a), "v"(b), "v"(c)); return r; }
__device__ __forceinline__ float max16v(const f32x4 (&s)[4]) {
    float a = max3f(s[0][0], s[0][1], s[0][2]), b = max3f(s[0][3], s[1][0], s[1][1]), c = max3f(s[1][2], s[1][3], s[2][0]), d = max3f(s[2][1], s[2][2], s[2][3]);
    a = max3f(a, s[3][0], s[3][1]); b = max3f(b, s[3][2], s[3][3]); return max3f(max3f(a, b, c), d, d);
}
template <int CGM>
__device__ __forceinline__ void pv2(f32x4 (&o)[2][4], const float (&p)[2][4][4], const unsigned char* Vs, int r, int fq) {
    bf16x8 pb[2][2];
#pragma unroll
    for (int cg_ = 0; cg_ < 2; ++cg_) if ((CGM >> cg_) & 1)
#pragma unroll
        for (int kc = 0; kc < 2; ++kc) {
            u32x4 w; w.x = cvt_pk_bf16(p[cg_][2 * kc][0], p[cg_][2 * kc][1]); w.y = cvt_pk_bf16(p[cg_][2 * kc][2], p[cg_][2 * kc][3]);
            w.z = cvt_pk_bf16(p[cg_][2 * kc + 1][0], p[cg_][2 * kc + 1][1]); w.w = cvt_pk_bf16(p[cg_][2 * kc + 1][2], p[cg_][2 * kc + 1][3]);
            pb[cg_][kc] = __builtin_bit_cast(bf16x8, w);
        }
#pragma unroll
    for (int df = 0; df < 4; ++df)
#pragma unroll
        for (int kc = 0; kc < 2; ++kc) {
            const int R = prow(df, r);
            const bf16x8 vf = *(const bf16x8*)(Vs + R * 128 + (((4 * kc + fq) ^ swz(R)) << 4));
            if (CGM & 1) o[0][df] = __builtin_amdgcn_mfma_f32_16x16x32_bf16(vf, pb[0][kc], o[0][df], 0, 0, 0);
            if (CGM & 2) o[1][df] = __builtin_amdgcn_mfma_f32_16x16x32_bf16(vf, pb[1][kc], o[1][df], 0, 0, 0);
        }
}
template <int CGM>
__device__ __forceinline__ void step_edge(const bf16x8 (&kf)[4][2], const bf16x8 (&q)[2][2], const int (&tq)[2], int key0, int fq, int H, const float* btab, int wl, const bool (&selq)[2],
                                          float (&m)[2], float (&l)[2], f32x4 (&o)[2][4], const unsigned char* Vs, int r) {
    float v[2][4][4]; float mnew[2] = {m[0], m[1]};
#pragma unroll
    for (int cg_ = 0; cg_ < 2; ++cg_) if ((CGM >> cg_) & 1) {
        f32x4 s[4]; qk(s, kf, q[cg_], 0.f); logits(v[cg_], s, tq[cg_], key0, 1, fq, H, btab, 0.f, true, wl);
        float mx = red_max4(max16(v[cg_])); if (!selq[cg_]) mx = -1e30f; mnew[cg_] = fmaxf(m[cg_], mx);
    }
    if (__any(mnew[0] > m[0] || mnew[1] > m[1])) {
#pragma unroll
        for (int cg_ = 0; cg_ < 2; ++cg_) if ((CGM >> cg_) & 1) {
            const float sc = __builtin_amdgcn_exp2f(m[cg_] - mnew[cg_]); l[cg_] *= sc; m[cg_] = mnew[cg_];
#pragma unroll
            for (int df = 0; df < 4; ++df) o[cg_][df] *= sc;
        }
    }
#pragma unroll
    for (int cg_ = 0; cg_ < 2; ++cg_) if ((CGM >> cg_) & 1) {
        const float moff = selq[cg_] ? m[cg_] : 1e30f; float rs = 0.f;
#pragma unroll
        for (int f = 0; f < 4; ++f)
#pragma unroll
            for (int i = 0; i < 4; ++i) { const float pe = __builtin_amdgcn_exp2f(v[cg_][f][i] - moff); v[cg_][f][i] = pe; rs += pe; }
        l[cg_] += rs;
    }
    pv2<CGM>(o, v, Vs, r, fq);
}
template <int CGM>
__device__ __forceinline__ void step_int(const bf16x8 (&kf)[4][2], const bf16x8 (&q)[2][2], float farb, const bool (&selq)[2],
                                         float (&m)[2], float (&l)[2], f32x4 (&o)[2][4], const unsigned char* Vs, int r, int fq) {
    f32x4 s[2][4]; float mx[2] = {-1e30f, -1e30f};
#pragma unroll
    for (int cg_ = 0; cg_ < 2; ++cg_) if ((CGM >> cg_) & 1) { qk(s[cg_], kf, q[cg_], selq[cg_] ? farb - m[cg_] : -1e30f); mx[cg_] = red_max4(max16v(s[cg_])); }
    if (__any(mx[0] > 0.f || mx[1] > 0.f)) {
#pragma unroll
        for (int cg_ = 0; cg_ < 2; ++cg_) if ((CGM >> cg_) & 1) {
            const float d = fmaxf(mx[cg_], 0.f), sc = __builtin_amdgcn_exp2f(-d); m[cg_] += d; l[cg_] *= sc;
#pragma unroll
            for (int df = 0; df < 4; ++df) o[cg_][df] *= sc;
#pragma unroll
            for (int f = 0; f < 4; ++f) s[cg_][f] -= d;
        }
    }
    float p[2][4][4];
#pragma unroll
    for (int cg_ = 0; cg_ < 2; ++cg_) if ((CGM >> cg_) & 1) {
        float rs = 0.f;
#pragma unroll
        for (int f = 0; f < 4; ++f)
#pragma unroll
            for (int i = 0; i < 4; ++i) { const float pe = __builtin_amdgcn_exp2f(s[cg_][f][i]); p[cg_][f][i] = pe; rs += pe; }
        l[cg_] += rs;
    }
    pv2<CGM>(o, p, Vs, r, fq);
}

template <bool SEL>
__device__ __forceinline__ void band_loop(unsigned char* lds, PG8_LAS unsigned char* lds3, const unsigned char* KV, int jhi, int jlo, int T, int wl,
                                          const bf16x8 (&q)[2][2], const int (&tq)[2], const unsigned long long (&sw)[2][2], int H, float farb,
                                          float (&m)[2], float (&l)[2], f32x4 (&o)[2][4], int wu, unsigned soff, int r, int fq) {
    const float* btab = (const float*)(lds + OFF_BT);
    const int n = jhi - jlo + 1;
    __syncthreads();
#pragma unroll
    for (int pi = 0; pi < 2; ++pi) if (pi < n) { const unsigned char* blk = KV + (size_t)(jhi - pi) * SLOTB; dma_block(lds3, pi, wu, blk, soff, blk + 8192, soff); }
    for (int it0 = 0; it0 < n; it0 += 2) {
        ring_wait_bar(0);
#pragma unroll
        for (int pi = 2; pi < 4; ++pi) if (it0 + pi < n) { const unsigned char* blk = KV + (size_t)(jhi - it0 - pi) * SLOTB; dma_block(lds3, (it0 + pi) & 3, wu, blk, soff, blk + 8192, soff); }
#pragma unroll 1
        for (int it = it0; it < it0 + 2 && it < n; ++it) {
            const int j = jhi - it, slot = it & 3;
            bool selq[2] = {true, true}; bool any[2] = {true, true};
            if (SEL) {
#pragma unroll
                for (int cg_ = 0; cg_ < 2; ++cg_) {
                    const unsigned long long wsel = j < 64 ? sw[cg_][0] : sw[cg_][1];
                    selq[cg_] = ((wsel >> (j & 63)) & 1ull) != 0ull; any[cg_] = __any(selq[cg_]) != 0;
                }
            }
            if (any[0] || any[1]) {
                const unsigned char* Ks = lds + OFF_RING + slot * SLOTB; const unsigned char* Vs = Ks + 8192;
                bf16x8 kf[4][2]; load_kfrags(kf, Ks, r, fq);
                const bool edge = (j >= T - 2) || (wl == 512 && j == T - 8);
                if (edge) {
                    if (any[0] && any[1]) step_edge<3>(kf, q, tq, j * 64, fq, H, btab, wl, selq, m, l, o, Vs, r);
                    else if (any[0]) step_edge<1>(kf, q, tq, j * 64, fq, H, btab, wl, selq, m, l, o, Vs, r);
                    else step_edge<2>(kf, q, tq, j * 64, fq, H, btab, wl, selq, m, l, o, Vs, r);
                } else {
                    if (any[0] && any[1]) step_int<3>(kf, q, farb, selq, m, l, o, Vs, r, fq);
                    else if (any[0]) step_int<1>(kf, q, farb, selq, m, l, o, Vs, r, fq);
                    else step_int<2>(kf, q, farb, selq, m, l, o, Vs, r, fq);
                }
            }
        }
    }
}

__device__ __forceinline__ void unitA(unsigned char* lds, PG8_LAS unsigned char* lds3, const Args& a, int b, int g, int T) {
    int tid = threadIdx.x; asm volatile("" : "+v"(tid));
    const int w = tid >> 6, wu = __builtin_amdgcn_readfirstlane(w), lane = tid & 63, c = lane & 15, fq = lane >> 4, hl = c & 3, r = c;
    const int H = 4 * g + hl, t0 = T * 64, bg = b * 2 + g;
    float* btab = (float*)(lds + OFF_BT); float* imp = (float*)(lds + OFF_IMP); unsigned* selm = (unsigned*)(lds + OFF_SEL);
    int tq[2]; bf16x8 q[2][2];
    f32x4* stash = (f32x4*)(lds + OFF_STASH);
#pragma unroll
    for (int cg_ = 0; cg_ < 2; ++cg_) {
        tq[cg_] = t0 + 8 * w + 4 * cg_ + (c >> 2);
        const bf16_t* rowp = a.PQ + (size_t)(b * SEQ + tq[cg_]) * PQ_LD;
#pragma unroll
        for (int dc = 0; dc < 2; ++dc) q[cg_][dc] = *(const bf16x8*)(rowp + H * 64 + 32 * dc + 8 * fq);
    }
#pragma unroll
    for (int cg_ = 0; cg_ < 2; ++cg_)
#pragma unroll
        for (int dc = 0; dc < 2; ++dc) asm volatile("" : "+v"(q[cg_][dc]));
    float gatev[3][2];
#pragma unroll
    for (int cg_ = 0; cg_ < 2; ++cg_)
#pragma unroll
        for (int br = 0; br < 3; ++br) { gatev[br][cg_] = bf2f(a.PQ[(size_t)(b * SEQ + tq[cg_]) * PQ_LD + 1280 + br * 8 + H]); asm volatile("" : "+v"(gatev[br][cg_])); }
#define GATE(br, cg_) fsigmoid(gatev[br][cg_])
    const float farb = btab[128 * 16 + H];
    const unsigned soff = src_off(w, lane, 128);
    __syncthreads();
    for (int i = tid; i < 64 * IMP_LD; i += 512) imp[i] = 0.f;
    f32x4 oc[2][4];
    for (int rep_ = 0; rep_ < REP_CMP; ++rep_) {
        const int NB = ((4 * T + 2) >> 6) + 1;
        const int ib_far = (64 * T - 1167) >= 0 ? (64 * T - 1167) / 1024 : -1;
        const unsigned char* Kb = (const unsigned char*)(a.KC + (size_t)bg * 512 * 64); const unsigned char* Vb = (const unsigned char*)(a.VCT + (size_t)bg * 64 * 512);
        const unsigned voffc = src_off(w, lane, 1024);
        float m[2] = {-1e30f, -1e30f}, l[2] = {0.f, 0.f}, moff[2];
        __syncthreads();
#pragma unroll
        for (int pi = 0; pi < 3; ++pi) if (pi < NB) dma_block(lds3, pi, wu, Kb + (size_t)pi * 8192, soff, Vb + pi * 128, voffc);
        for (int ib = 0; ib < NB; ++ib) {
            ring_wait_bar(NB - 1 - ib);
            if (ib + 3 < NB) dma_block(lds3, (ib + 3) & 3, wu, Kb + (size_t)(ib + 3) * 8192, soff, Vb + (ib + 3) * 128, voffc);
            const unsigned char* Ks = lds + OFF_RING + (ib & 3) * SLOTB;
            bf16x8 kf[4][2]; load_kfrags(kf, Ks, r, fq);
            const bool edge = ib > ib_far;
#pragma unroll
            for (int cg_ = 0; cg_ < 2; ++cg_) {
                f32x4 s[4]; float v[4][4];
                if (edge) { qk(s, kf, q[cg_], 0.f); logits(v, s, tq[cg_], 16 * 64 * ib + 31, 16, fq, H, btab, farb, true, 1 << 30); }
                else { qk(s, kf, q[cg_], farb);
#pragma unroll
                    for (int f = 0; f < 4; ++f)
#pragma unroll
                        for (int i = 0; i < 4; ++i) v[f][i] = s[f][i]; }
                const float mx = red_max4(max16(v)), mnew = fmaxf(m[cg_], mx), sc = __builtin_amdgcn_exp2f(m[cg_] - mnew); m[cg_] = mnew;
                float rs = 0.f;
#pragma unroll
                for (int f = 0; f < 4; ++f)
#pragma unroll
                    for (int i = 0; i < 4; ++i) rs += v[f][i] > -1e29f ? __builtin_amdgcn_exp2f(v[f][i] - mnew) : 0.f;
                l[cg_] = l[cg_] * sc + rs;
            }
        }
#pragma unroll
        for (int cg_ = 0; cg_ < 2; ++cg_) { const float lt = quad_sum(l[cg_]); moff[cg_] = lt > 0.f ? m[cg_] + __builtin_amdgcn_logf(lt) : 1e30f; }
#pragma unroll
        for (int cg_ = 0; cg_ < 2; ++cg_)
#pragma unroll
            for (int df = 0; df < 4; ++df) oc[cg_][df] = (f32x4){0.f, 0.f, 0.f, 0.f};
        __syncthreads();
#pragma unroll
        for (int pi = 0; pi < 3; ++pi) if (pi < NB) dma_block(lds3, pi, wu, Kb + (size_t)pi * 8192, soff, Vb + pi * 128, voffc);
        for (int ib = 0; ib < NB; ++ib) {
            ring_wait_bar(NB - 1 - ib);
            if (ib + 3 < NB) dma_block(lds3, (ib + 3) & 3, wu, Kb + (size_t)(ib + 3) * 8192, soff, Vb + (ib + 3) * 128, voffc);
            const unsigned char* Ks = lds + OFF_RING + (ib & 3) * SLOTB; const unsigned char* Vs = Ks + 8192;
            bf16x8 kf[4][2]; load_kfrags(kf, Ks, r, fq);
            const bool edge = ib > ib_far;
#pragma unroll
            for (int cg_ = 0; cg_ < 2; ++cg_) {
                f32x4 s[4]; float v[4][4];
                if (edge) { qk(s, kf, q[cg_], 0.f); logits(v, s, tq[cg_], 16 * 64 * ib + 31, 16, fq, H, btab, farb, true, 1 << 30);
#pragma unroll
                    for (int f = 0; f < 4; ++f)
#pragma unroll
                        for (int i = 0; i < 4; ++i) v[f][i] -= moff[cg_]; }
                else { qk(s, kf, q[cg_], farb - moff[cg_]);
#pragma unroll
                    for (int f = 0; f < 4; ++f)
#pragma unroll
                        for (int i = 0; i < 4; ++i) v[f][i] = s[f][i]; }
                const int qi = 8 * w + 4 * cg_ + (c >> 2);
#pragma unroll
                for (int f = 0; f < 4; ++f) {
#pragma unroll
                    for (int i = 0; i < 4; ++i) v[f][i] = __builtin_amdgcn_exp2f(v[f][i]);
                    float pa = v[f][0] + v[f][1] + v[f][2] + 0.5f * v[f][3], pb = 0.5f * v[f][3];
                    pa += dpp_xor1(pa); pa += dpp_xor2(pa); pb += dpp_xor1(pb); pb += dpp_xor2(pb);
                    if (hl == 0) { const int jj = 16 * ib + 8 * (f >> 1) + 2 * fq + (f & 1); atomicAdd(&imp[qi * IMP_LD + jj], pa); atomicAdd(&imp[qi * IMP_LD + jj + 1], pb); }
                }
                pv(oc[cg_], v, Vs, r, fq);
            }
        }
    }
    __syncthreads();
    for (int rep_ = 0; rep_ < REP_TOPK; ++rep_) {
        const int qi = 8 * w + (lane >> 3), gq = lane & 7;
        unsigned m16 = 0u;
        if (T <= 15) {
#pragma unroll
            for (int i = 0; i < 16; ++i) m16 |= (16 * gq + i <= T) ? (1u << i) : 0u;
        } else {
            unsigned u[16];
#pragma unroll
            for (int i = 0; i < 16; ++i) { const int j = 16 * gq + i; u[i] = (j >= 1 && j <= T - 2) ? __float_as_uint(imp[qi * IMP_LD + j]) : 0u; }
            unsigned thr = 0u;
            for (int bit = 30; bit >= 0; --bit) {
                const unsigned cand = thr | (1u << bit);
                int cnt = 0;
#pragma unroll
                for (int i = 0; i < 16; ++i) cnt += (u[i] >= cand) ? 1 : 0;
                cnt += __builtin_amdgcn_update_dpp(0, cnt, 0xB1, 0xF, 0xF, true); cnt += __builtin_amdgcn_update_dpp(0, cnt, 0x4E, 0xF, 0xF, true); cnt += __builtin_amdgcn_update_dpp(0, cnt, 0x141, 0xF, 0xF, true);
                if (cnt >= 13) thr = cand;
            }
            int ngt = 0, neq = 0;
#pragma unroll
            for (int i = 0; i < 16; ++i) { const int j = 16 * gq + i; ngt += (u[i] > thr) ? 1 : 0; neq += (u[i] == thr && j >= 1 && j <= T - 2) ? 1 : 0; }
            ngt += __builtin_amdgcn_update_dpp(0, ngt, 0xB1, 0xF, 0xF, true); ngt += __builtin_amdgcn_update_dpp(0, ngt, 0x4E, 0xF, 0xF, true); ngt += __builtin_amdgcn_update_dpp(0, ngt, 0x141, 0xF, 0xF, true);
            int before = 0;
#pragma unroll
            for (int g2 = 0; g2 < 7; ++g2) { const int other = __shfl(neq, (lane & ~7) | g2); before += (g2 < gq) ? other : 0; }
            int need = 13 - ngt - before;
#pragma unroll
            for (int i = 0; i < 16; ++i) {
                const int j = 16 * gq + i; bool sel = u[i] > thr;
                if (u[i] == thr && j >= 1 && j <= T - 2) { sel = need > 0; --need; }
                if (j == 0 || j == T - 1 || j == T) sel = true;
                m16 |= sel ? (1u << i) : 0u;
            }
        }
        const unsigned hi = (unsigned)__builtin_amdgcn_update_dpp(0, (int)m16, 0xB1, 0xF, 0xF, true);
        if ((gq & 1) == 0) selm[qi * 4 + (gq >> 1)] = m16 | (hi << 16);
    }
    __syncthreads();
#pragma unroll
    for (int cg_ = 0; cg_ < 2; ++cg_) { const float gsc = GATE(0, cg_);
#pragma unroll
        for (int df = 0; df < 4; ++df) stash[(cg_ * 4 + df) * 512 + tid] = oc[cg_][df] * gsc; }
    unsigned long long sw[2][2];
#pragma unroll
    for (int cg_ = 0; cg_ < 2; ++cg_) { const unsigned* sp = selm + (8 * w + 4 * cg_ + (c >> 2)) * 4;
        sw[cg_][0] = (unsigned long long)sp[0] | ((unsigned long long)sp[1] << 32); sw[cg_][1] = (unsigned long long)sp[2] | ((unsigned long long)sp[3] << 32); }
    for (int rep_ = 0; rep_ < REP_SEL; ++rep_) {
        float m[2] = {-1e30f, -1e30f}, l[2] = {0.f, 0.f}; f32x4 o[2][4];
#pragma unroll
        for (int cg_ = 0; cg_ < 2; ++cg_)
#pragma unroll
            for (int df = 0; df < 4; ++df) o[cg_][df] = (f32x4){0.f, 0.f, 0.f, 0.f};
        band_loop<true>(lds, lds3, (const unsigned char*)a.KVS + (size_t)bg * 128 * SLOTB, T, 0, T, 1 << 30, q, tq, sw, H, farb, m, l, o, wu, soff, r, fq);
        if (rep_ == REP_SEL - 1)
#pragma unroll
        for (int cg_ = 0; cg_ < 2; ++cg_) { const float sc = GATE(1, cg_) / quad_sum(l[cg_]);
#pragma unroll
            for (int df = 0; df < 4; ++df) stash[(cg_ * 4 + df) * 512 + tid] += o[cg_][df] * sc; }
    }
    for (int rep_ = 0; rep_ < REP_WIN; ++rep_) {
        float m[2] = {-1e30f, -1e30f}, l[2] = {0.f, 0.f}; f32x4 o[2][4];
#pragma unroll
        for (int cg_ = 0; cg_ < 2; ++cg_)
#pragma unroll
            for (int df = 0; df < 4; ++df) o[cg_][df] = (f32x4){0.f, 0.f, 0.f, 0.f};
        band_loop<false>(lds, lds3, (const unsigned char*)a.KVW + (size_t)bg * 128 * SLOTB, T, T - 8 > 0 ? T - 8 : 0, T, 512, q, tq, sw, H, farb, m, l, o, wu, soff, r, fq);
        if (rep_ == REP_WIN - 1)
#pragma unroll
        for (int cg_ = 0; cg_ < 2; ++cg_) { const float sc = GATE(2, cg_) / quad_sum(l[cg_]);
            bf16_t* op = a.OA + (size_t)(b * SEQ + tq[cg_]) * 1024 + H * 64 + 8 * fq;
#pragma unroll
            for (int e = 0; e < 2; ++e) {
                const f32x4 x0 = stash[(cg_ * 4 + 2 * e) * 512 + tid] + o[cg_][2 * e] * sc, x1 = stash[(cg_ * 4 + 2 * e + 1) * 512 + tid] + o[cg_][2 * e + 1] * sc;
                u32x4 wv; wv.x = cvt_pk_bf16(x0[0], x0[1]); wv.y = cvt_pk_bf16(x0[2], x0[3]); wv.z = cvt_pk_bf16(x1[0], x1[1]); wv.w = cvt_pk_bf16(x1[2], x1[3]);
                *(u32x4*)(op + 32 * e) = wv;
            }
        }
    }
#undef GATE
}
__device__ __forceinline__ void unitB(unsigned char* lds, PG8_LAS unsigned char* lds3, const Args& a, int b, int kvh, int T) {
    int tid = threadIdx.x; asm volatile("" : "+v"(tid));
    const int w = tid >> 6, wu = __builtin_amdgcn_readfirstlane(w), lane = tid & 63, c = lane & 15, fq = lane >> 4, hl = c & 3, r = c;
    const int hb = 4 * kvh + hl, H = 8 + hb, t0 = T * 64, bg = b * 2 + kvh;
    const float* btab = (const float*)(lds + OFF_BT);
    int tq[2]; bf16x8 q[2][2]; unsigned long long sw[2][2];
#pragma unroll
    for (int cg_ = 0; cg_ < 2; ++cg_) {
        tq[cg_] = t0 + 8 * w + 4 * cg_ + (c >> 2);
        const bf16_t* rowp = a.PQ + (size_t)(b * SEQ + tq[cg_]) * PQ_LD;
#pragma unroll
        for (int dc = 0; dc < 2; ++dc) q[cg_][dc] = *(const bf16x8*)(rowp + 1304 + hb * 64 + 32 * dc + 8 * fq);
        sw[cg_][0] = 0ull; sw[cg_][1] = 0ull;
    }
#pragma unroll
    for (int cg_ = 0; cg_ < 2; ++cg_)
#pragma unroll
        for (int dc = 0; dc < 2; ++dc) asm volatile("" : "+v"(q[cg_][dc]));
    const float farb = btab[128 * 16 + H];
    const unsigned soff = src_off(w, lane, 128);
    float m[2] = {-1e30f, -1e30f}, l[2] = {0.f, 0.f}; f32x4 o[2][4];
#pragma unroll
    for (int cg_ = 0; cg_ < 2; ++cg_)
#pragma unroll
        for (int df = 0; df < 4; ++df) o[cg_][df] = (f32x4){0.f, 0.f, 0.f, 0.f};
    band_loop<false>(lds, lds3, (const unsigned char*)a.KVB + (size_t)bg * 128 * SLOTB, T, T - 2 > 0 ? T - 2 : 0, T, 128, q, tq, sw, H, farb, m, l, o, wu, soff, r, fq);
    const float sink2 = a.sinks[hb] * LOG2E;
#pragma unroll
    for (int cg_ = 0; cg_ < 2; ++cg_) {
        const float lt = quad_sum(l[cg_]) + __builtin_amdgcn_exp2f(sink2 - m[cg_]); const float sc = 1.0f / lt;
        bf16_t* op = a.OB + (size_t)(b * SEQ + tq[cg_]) * 1024 + hb * 64 + 8 * fq;
#pragma unroll
        for (int e = 0; e < 2; ++e) {
            u32x4 wv; wv.x = cvt_pk_bf16(o[cg_][2 * e][0] * sc, o[cg_][2 * e][1] * sc); wv.y = cvt_pk_bf16(o[cg_][2 * e][2] * sc, o[cg_][2 * e][3] * sc);
            wv.z = cvt_pk_bf16(o[cg_][2 * e + 1][0] * sc, o[cg_][2 * e + 1][1] * sc); wv.w = cvt_pk_bf16(o[cg_][2 * e + 1][2] * sc, o[cg_][2 * e + 1][3] * sc);
            *(u32x4*)(op + 32 * e) = wv;
        }
    }
}
}

#define LAS __attribute__((address_space(3)))
#define XB_TMO      128
#define XB_XCNT(j)  (256  + 64 * (j))
#define XB_XSUB(j)  (1280 + 64 * (j))
#define XB_XGEN(j)  (2304 + 64 * (j))
#define XB_TOP      3328
#define XB_TOPGEN   3392
#define XCD_BAR_WORDS 3456
#define XB_SPIN_CAP (1u << 18)

__device__ __forceinline__ unsigned xb_ld(unsigned* p)              { return __hip_atomic_load(p, __ATOMIC_RELAXED, __HIP_MEMORY_SCOPE_AGENT); }
__device__ __forceinline__ unsigned xb_add(unsigned* p, unsigned v) { return __hip_atomic_fetch_add(p, v, __ATOMIC_RELAXED, __HIP_MEMORY_SCOPE_AGENT); }
__device__ __forceinline__ unsigned xb_xcc_id() { return (unsigned)__builtin_amdgcn_s_getreg((3 << 11) | 20) & 0xFu; }
#define XB_SPIN(cond, bar) do { unsigned _sp = 0; while (cond) { __builtin_amdgcn_s_sleep(1); \
    if ((++_sp & 255u) == 0u) { if (xb_ld(&(bar)[XB_TMO])) break; if (_sp > XB_SPIN_CAP) { atomicAdd(&(bar)[XB_TMO], 1u); break; } } } } while (0)

struct XcdBarrier {
    unsigned* bar; unsigned x;
    volatile LAS unsigned* st;
};

__device__ __forceinline__ XcdBarrier xcd_barrier_post(unsigned* bar, volatile LAS unsigned* st) {
    XcdBarrier b; b.bar = bar; b.x = xb_xcc_id(); b.st = st;
    if (threadIdx.x == 0) (void)xb_add(&bar[XB_XCNT(b.x)], 1u);
    return b;
}
__device__ __forceinline__ void xcd_barrier_complete(unsigned* bar, unsigned x, unsigned& nloc, unsigned& nx) {
    const unsigned G = gridDim.x * gridDim.y * gridDim.z;
    unsigned sum, cnt, mine, sp = 0u;
    for (;;) {
        sum = 0u; cnt = 0u; mine = 0u;
#pragma unroll
        for (unsigned j = 0; j < 16; ++j) { const unsigned c = xb_ld(&bar[XB_XCNT(j)]); sum += c; cnt += (c > 0u) ? 1u : 0u; mine = (j == x) ? c : mine; }
        if (sum == G) break;
        __builtin_amdgcn_s_sleep(1);
        if ((++sp & 255u) == 0u) { if (xb_ld(&bar[XB_TMO])) break; if (sp > XB_SPIN_CAP) { atomicAdd(&bar[XB_TMO], 1u); break; } }
    }
    nloc = mine > 0u ? mine : 1u; nx = cnt > 0u ? cnt : 1u;
}

__device__ __forceinline__ void xcd_barrier(const XcdBarrier& b) {
    asm volatile("s_waitcnt vmcnt(0)" ::: "memory");
    __syncthreads();
    if (threadIdx.x == 0) {
        unsigned* bar = b.bar;
        __builtin_amdgcn_s_waitcnt(0);
        __builtin_amdgcn_fence(__ATOMIC_RELEASE, "agent");
        asm volatile("s_waitcnt vmcnt(0)" ::: "memory");
        unsigned nloc = b.st[0], nx = b.st[1];
        if (nloc == 0u) { xcd_barrier_complete(bar, b.x, nloc, nx); b.st[0] = nloc; b.st[1] = nx; }
        const unsigned old = xb_add(&bar[XB_XSUB(b.x)], 1u);
        const unsigned gen = old / nloc;
        if (old + 1u == (gen + 1u) * nloc) {
            __builtin_amdgcn_fence(__ATOMIC_RELEASE, "agent");
            asm volatile("s_waitcnt vmcnt(0)" ::: "memory");
            const unsigned og = xb_add(&bar[XB_TOP], 1u);
            const unsigned tg = og / nx;
            if (og + 1u == (tg + 1u) * nx) xb_add(&bar[XB_TOPGEN], 1u);
            else XB_SPIN(xb_ld(&bar[XB_TOPGEN]) == tg, bar);
            __builtin_amdgcn_fence(__ATOMIC_ACQUIRE, "agent");
            xb_add(&bar[XB_XGEN(b.x)], 1u);
            asm volatile("s_waitcnt vmcnt(0)" ::: "memory");
        } else {
            XB_SPIN(xb_ld(&bar[XB_XGEN(b.x)]) == gen, bar);
            __builtin_amdgcn_fence(__ATOMIC_ACQUIRE, "agent");
            asm volatile("s_waitcnt vmcnt(0)" ::: "memory");
        }
    }
    __syncthreads();
}


struct CmpOrder {
    int G, c, lda, ldb;
    __device__ bool next(int i, pg8::Unit& u) const { const int L = i * G + c; if (L >= 64) return false; u.pm = L; u.pn = 0; u.aoff = (long)L * 256 * lda; u.boff = (long)(L >> 5) * 256 * ldb; return true; }
};
struct CmpOrderA {
    int G, c;
    __device__ bool next(int i, pg8::Unit& u) const {
        const int L = i * G + c; if (L >= 64) return false;
        const int kv = L >> 5, r = L & 31, bg = r >> 1, half = r & 1, b = bg >> 1, g = bg & 1;
        u.pm = L; u.pn = 0; u.aoff = (long)(b * SEQ + 16 * 256 * half) * PQ_LD + 512 + kv * 128 + g * 64; u.boff = (long)kv * 256 * 2048; return true;
    }
};
struct MemOrder {
    int c, c0, mode;
    __device__ bool next(int i, pg8::Unit& u) const {
        if (i > 0 || c < c0 || c >= c0 + 32) return false; const int L = c - c0;
        if (mode == 0) { u.pm = L >> 2; u.pn = L & 3; } else { u.pm = L >> 3; u.pn = L & 7; }
        u.aoff = (long)u.pm * 256 * 1024; u.boff = (long)u.pn * 256 * 1024; return true;
    }
};
struct XOrder {
    int G, c, mode;
    __device__ bool next(int i, pg8::Unit& u) const {
        const int L = i * G + c; if (L >= 1024) return false;
        const int h = L & 3, pm = L >> 2, b = pm >> 5;
        u.pm = pm; u.pn = h; u.aoff = (long)pm * 256 * 1024 + h * 256;
        u.boff = mode == 0 ? (long)(b * 256) * 1024 + h * 256 : (long)(h * 256) * 2048 + b * 256;
        if (mode == 2) { u.aoff = (long)pm * 256 * 1024; u.boff = (long)h * 256 * 1024; }
        return true;
    }
};

__global__ void __launch_bounds__(512, 2) fwd_megakernel(Params p) {
    extern __shared__ __attribute__((aligned(16))) unsigned char lds[];
    cg::grid_group grid = cg::this_grid();
    PG8_LAS unsigned char* lds3 = (PG8_LAS unsigned char*)lds;
    const int wave = __builtin_amdgcn_readfirstlane(threadIdx.x >> 6), G = gridDim.x, bid = blockIdx.x;
    const int gw = bid * 8 + wave, NGW = G * 8;
#define GSYNC() xcd_barrier(xbar)
#define LOCAL_TID int tid = threadIdx.x; asm volatile("" : "+v"(tid)); const int lane = tid & 63; (void)lane;
    unsigned char* ws = p.ws; unsigned char* dob = (unsigned char*)p.out;
    float* CBP = (float*)(ws + WS_CB); float* CB = CBP + 2 * 64 * 256;
    float* Lacc = (float*)(ws + WS_LP); float* SS = (float*)(ws + WS_SS);
    bf16_t* W1GU = (bf16_t*)(ws + WS_W1GU); bf16_t* W1D = (bf16_t*)(ws + WS_W1D); bf16_t* W2GU = (bf16_t*)(ws + WS_W2GU); bf16_t* W2D = (bf16_t*)(ws + WS_W2D);
    bf16_t* WIN = (bf16_t*)(ws + WS_WIN); bf16_t* WC1 = (bf16_t*)(ws + WS_WC1); bf16_t* WC2 = (bf16_t*)(ws + WS_WC2);
    bf16_t* WUA = (bf16_t*)(ws + WS_WUA); bf16_t* WUB = (bf16_t*)(ws + WS_WUB); bf16_t* WOUT = (bf16_t*)(ws + WS_WOUT);
    bf16_t* WXQ = (bf16_t*)(ws + WS_WXQ); bf16_t* WXKV = (bf16_t*)(ws + WS_WXKV); bf16_t* WXO = (bf16_t*)(ws + WS_WXO);
    bf16_t* XN = (bf16_t*)(ws + WS_XN); bf16_t* OA = (bf16_t*)(ws + WS_OA); bf16_t* OB = OA + 512;
    bf16_t* Hb = (bf16_t*)(ws + WS_H); bf16_t* PQ = (bf16_t*)(ws + WS_PQ); bf16_t* PG = (bf16_t*)(ws + WS_PG); bf16_t* MERGED = (bf16_t*)(ws + WS_MERGED);
    bf16_t* QX = (bf16_t*)(ws + WS_QX); bf16_t* PX = (bf16_t*)(ws + WS_PX); bf16_t* OX = (bf16_t*)(ws + WS_OX);
    bf16_t* MEMN = (bf16_t*)(ws + WS_MEMN); bf16_t* KM = (bf16_t*)(ws + WS_KM); bf16_t* VMT = (bf16_t*)(ws + WS_VMT);
    bf16_t* ACMP = (bf16_t*)(dob + DO_ACMP); bf16_t* HC = (bf16_t*)(dob + DO_HC); bf16_t* KC = (bf16_t*)(dob + DO_KC); bf16_t* VCT = (bf16_t*)(dob + DO_VCT);
    bf16_t* KVS = (bf16_t*)(dob + DO_KVS); bf16_t* KVW = (bf16_t*)(dob + DO_KVW); bf16_t* KVB = (bf16_t*)(dob + DO_KVB); float* Tb = (float*)(dob + DO_T);

    {
        LOCAL_TID
        float* scr = (float*)(lds + wave * 16384);
#define CONVX(idx, K_, N_, dst, ldd, kofs, kind, roff, gptr) for (int it = gw; it < ((K_) / 64) * (((N_) + 31) / 32); it += NGW) conv_item(p.in[idx], K_, N_, dst, ldd, kofs, kind, roff, gptr, scr, it, lane)
#define CONVG(idx, K_, N_, dst, kind, roff, gptr) CONVX(idx, K_, N_, dst, K_, 0, kind, roff, gptr)
#define CONV(idx, K_, N_, dst, kind, roff) CONVG(idx, K_, N_, dst, kind, roff, nullptr)
        CONV(3, 1024, 2816, W1GU, 1, 0); CONV(4, 1024, 2816, W1GU, 2, 0); CONV(5, 2816, 1024, W1D, 0, 0);
        CONVG(25, 1024, 2816, W2GU, 1, 0, p.in[24]); CONVG(26, 1024, 2816, W2GU, 2, 0, p.in[24]); CONV(27, 2816, 1024, W2D, 0, 0);
        CONVG(7, 1024, 4120, WIN, 3, 0, p.in[6]);
        CONV(9, 2048, 256, WC1, 0, 0); CONV(12, 2048, 256, WC1, 0, 256);
        CONV(10, 256, 64, WC2, 0, 0); CONV(13, 256, 64, WC2, 0, 256);
        CONVX(16, 512, 1024, WUA, 1024, 0, 0, 0, nullptr); CONVX(17, 512, 1024, WUA, 1024, 512, 0, 0, nullptr);   CONV(18, 1024, 1024, WOUT, 0, 0);
        CONVG(21, 1024, 1024, WXQ, 4, 0, p.in[19]); CONV(22, 1024, 2048, WXKV, 0, 0); CONV(23, 1024, 1024, WXO, 0, 0);
#undef CONV
#undef CONVG
#undef CONVX
        const int gt = bid * 512 + tid, GT = G * 512;
        for (int i = gt; i < 232 * 1024 / 8; i += GT) *((u32x4*)(WIN + (size_t)2072 * 1024) + i) = (u32x4){0u, 0u, 0u, 0u};
        for (int i = gt; i < 192 * 256 / 8; i += GT) { *((u32x4*)(WC2 + 64 * 256) + i) = (u32x4){0u, 0u, 0u, 0u}; *((u32x4*)(WC2 + 320 * 256) + i) = (u32x4){0u, 0u, 0u, 0u}; }
        rms_pass(p.in[0], p.in[2], XN, nullptr, M, gw, NGW);
        rms_pass(p.in[1], p.in[20], MEMN, nullptr, 2048, gw, NGW);
        for (int t = gw; t < 512; t += NGW) {
            const int kv = t >> 8, kc = (t >> 2) & 63, c = (t & 3) * 64 + lane; const float* pe = p.in[kv ? 11 : 8] + kc * 32; const float* w1 = p.in[kv ? 12 : 9] + (size_t)kc * 32 * 256 + c;
            float a0 = 0.f, a1 = 0.f, a2 = 0.f, a3 = 0.f;
            for (int k = 0; k < 32; k += 4) { a0 += pe[k] * w1[(size_t)k * 256]; a1 += pe[k + 1] * w1[(size_t)(k + 1) * 256]; a2 += pe[k + 2] * w1[(size_t)(k + 2) * 256]; a3 += pe[k + 3] * w1[(size_t)(k + 3) * 256]; }
            CBP[(kv * 64 + kc) * 256 + c] = (a0 + a1) + (a2 + a3);
        }
        if (bid == 0) for (int i = tid; i < (int)(BAR_BYTES / 4); i += 512) ((unsigned*)p.ws)[i] = 0u;
    }
    grid.sync();
    { volatile LAS unsigned* st = (volatile LAS unsigned*)(lds3 + BAR_LDS_OFF); if (threadIdx.x < 2) st[threadIdx.x] = 0u; __syncthreads(); }
    const XcdBarrier xbar = xcd_barrier_post((unsigned*)p.ws, (volatile LAS unsigned*)(lds3 + BAR_LDS_OFF));
    { const int gt = bid * 512 + (int)threadIdx.x; if (gt < 512) { float t0 = 0.f, t1 = 0.f, t2 = 0.f, t3 = 0.f; for (int kc = 0; kc < 64; kc += 4) { const float* q_ = CBP + ((gt >> 8) * 64 + kc) * 256 + (gt & 255); t0 += q_[0]; t1 += q_[256]; t2 += q_[512]; t3 += q_[768]; } CB[gt] = (t0 + t1) + (t2 + t3); } }
    { pg8::Gemm g{XN, W1GU, 1024, 1024, 1024}; pg8::StaticOrder S; S.init(M, 5632, 1024, 1024, G, bid); pg8::EpiSwiglu E{Hb, DFF, nullptr}; pg8::gemm_phase(lds3, g, S, E); }
    GSYNC();
    { pg8::Gemm g{Hb, W1D, DFF, DFF, DFF}; pg8::StaticOrder S; S.init(M, 1024, DFF, DFF, G, bid); pg8::EpiResid E{p.in[0], XN, SS, 0.5f}; pg8::gemm_phase(lds3, g, S, E); }
    GSYNC();
    { pg8::Gemm g{XN, WIN, 1024, 1024, 1024}; pg8::StaticOrder S; S.init(M, 4352, 1024, 1024, G, bid); pg8::EpiBf16 E{PQ, PQ_LD, 9, PG, PG_LD, 0, 1, nullptr, SS, nullptr}; pg8::gemm_phase(lds3, g, S, E); }
    GSYNC();
    { pg8::Gemm g{PQ, WC1, 16 * PQ_LD, 2048, 2048, PQ_LD * 2}; CmpOrderA S{G, bid}; pg8::EpiBf16 E{HC, 256, 1 << 30, nullptr, 0, 2, 0, nullptr, nullptr, CB}; pg8::gemm_phase(lds3, g, S, E); }
    { pg8::Gemm g{MEMN, WXKV, 1024, 1024, 1024}; MemOrder S{bid, G >= 128 ? 64 : 0, 0}; pg8::EpiBf16 E{KM, 1024, 1 << 30, nullptr, 0, 0, 0, nullptr, nullptr, nullptr}; pg8::gemm_phase(lds3, g, S, E); }
    if (G < 128 || bid >= 64) {
        LOCAL_TID
        const int cb0 = G < 128 ? bid : bid - 64, cG = G < 128 ? G : G - 64;
        bf16_t* tile = (bf16_t*)lds;
        for (int it0 = cb0; it0 < 3 * 16 * 128; it0 += 2 * cG) {
            const int row = tid >> 3, ch = tid & 7;
            const bool two = (it0 + cG) < 3 * 16 * 128;
            u32x4 kx[2], vx[2]; bf16_t* blk[2];
#pragma unroll
            for (int z = 0; z < 2; ++z) {
                const int it = (z == 0 || two) ? it0 + z * cG : it0;
                const int tb = it & 127, bg = (it >> 7) & 15, x = it >> 11, b = bg >> 1, g = bg & 1;
                const int kcol = (x == 0 ? 768 : (x == 1 ? 1024 : 1816)) + g * 64, vcol = (x == 0 ? 896 : (x == 1 ? 1152 : 1944)) + g * 64;
                blk[z] = (x == 0 ? KVS : (x == 1 ? KVW : KVB)) + (size_t)(bg * 128 + tb) * 8192;
                const bf16_t* src = PQ + (size_t)(b * SEQ + tb * 64 + row) * PQ_LD;
                kx[z] = *(const u32x4*)(src + kcol + ch * 8); vx[z] = *(const u32x4*)(src + vcol + ch * 8);
            }
            __syncthreads();
#pragma unroll
            for (int z = 0; z < 2; ++z) { if (z == 0 || two) *(u32x4*)(blk[z] + row * 64 + ch * 8) = kx[z]; *(u32x4*)(tile + z * 64 * 72 + row * 72 + ch * 8) = vx[z]; }
            __syncthreads();
#pragma unroll
            for (int z = 0; z < 2; ++z) {
                unsigned short e[8];
#pragma unroll
                for (int k = 0; k < 8; ++k) e[k] = tile[z * 64 * 72 + (ch * 8 + k) * 72 + row];
                u32x4 o; o.x = e[0] | ((unsigned)e[1] << 16); o.y = e[2] | ((unsigned)e[3] << 16); o.z = e[4] | ((unsigned)e[5] << 16); o.w = e[6] | ((unsigned)e[7] << 16);
                if (z == 0 || two) *(u32x4*)(blk[z] + 4096 + row * 64 + ch * 8) = o;
            }
        }
        __syncthreads();
    }
    { pg8::Gemm g{WXKV + (size_t)1024 * 1024, MEMN, 1024, 1024, 1024}; MemOrder S{bid, G >= 128 ? 96 : 0, 1}; pg8::EpiBf16 E{VMT, 2048, 1 << 30, nullptr, 0, 0, 0, nullptr, nullptr, nullptr}; pg8::gemm_phase(lds3, g, S, E); }
    GSYNC();
    { pg8::Gemm g{HC, WC2, 256, 256, 256}; CmpOrder S{G, bid, 256, 256}; pg8::EpiCmp2 E{KC, VCT}; pg8::gemm_phase(lds3, g, S, E); }
    GSYNC();
    {
        LOCAL_TID
        float* btab = (float*)(lds + att::OFF_BT);
        __syncthreads();
        for (int i = tid; i < 129 * 16; i += 512) { const int d = i >> 4, hh = i & 15; const int bk = d < 128 ? BUCKET_TAB[d] : 31; btab[i] = p.in[15][bk * 16 + hh] * LOG2E; }
        __syncthreads();
        att::Args a{PQ, KC, VCT, KVS, KVW, KVB, OA, OB, p.in[14]};
        const bool xo = (G == 256); const int nun = xo ? 8 : (2048 - bid + G - 1) / G;
        for (int i = 0; i < 2 * nun; ++i) {
            const int iu = i < nun ? i : i - nun; int bg, T;
            if (xo) { const int x = bid & 7, wi = bid >> 3, ii = iu & 3; bg = (iu < 4) ? x : x + 8; T = ii == 0 ? wi : (ii == 1 ? 63 - wi : (ii == 2 ? 64 + wi : 127 - wi)); }
            else { const int idx = bid + iu * G, tt = idx >> 4, i2 = tt >> 4, k = tt & 15; bg = idx & 15; T = (i2 & 1) ? (16 * i2 + 15 - k) : (16 * i2 + k); }
            if (i < nun) att::unitA(lds, lds3, a, bg >> 1, bg & 1, T); else att::unitB(lds, lds3, a, bg >> 1, bg & 1, T);
        }
        __syncthreads();
    }
    GSYNC();
    { pg8::Gemm g{OA, WUA, 1024, 1024, 1024}; pg8::StaticOrder S; S.init(M, 1024, 1024, 1024, G, bid); pg8::EpiGate E{PG, PG_LD, MERGED}; pg8::gemm_phase(lds3, g, S, E); }
    GSYNC();
    { pg8::Gemm g{MERGED, WOUT, 1024, 1024, 1024}; pg8::StaticOrder S; S.init(M, 1024, 1024, 1024, G, bid); pg8::EpiResid E{nullptr, XN, SS + (size_t)16 * M, 1.0f}; pg8::gemm_phase(lds3, g, S, E); }
    GSYNC();
    { pg8::Gemm g{XN, WXQ, 1024, 1024, 1024}; XOrder S{G, bid, 2}; pg8::EpiBf16 E{QX, 1024, 1 << 30, nullptr, 0, 0, 0, nullptr, SS + (size_t)16 * M, nullptr}; pg8::gemm_phase(lds3, g, S, E); }
    GSYNC();
    { pg8::Gemm g{QX, KM, 1024, 1024, 256}; XOrder S{G, bid, 0}; pg8::EpiXS E{PX, Lacc}; pg8::gemm_phase(lds3, g, S, E); }
    GSYNC();
    { pg8::Gemm g{PX, VMT, 1024, 2048, 256}; XOrder S{G, bid, 1}; pg8::EpiBf16 E{OX, 1024, 1 << 30, nullptr, 0, 0, 0, Lacc, nullptr, nullptr}; pg8::gemm_phase(lds3, g, S, E); }
    GSYNC();
    { pg8::Gemm g{OX, WXO, 1024, 1024, 1024}; pg8::StaticOrder S; S.init(M, 1024, 1024, 1024, G, bid); pg8::EpiResid E{nullptr, XN, SS + (size_t)32 * M, 1.0f}; pg8::gemm_phase(lds3, g, S, E); }
    GSYNC();
    { pg8::Gemm g{XN, W2GU, 1024, 1024, 1024}; pg8::StaticOrder S; S.init(M, 5632, 1024, 1024, G, bid); pg8::EpiSwiglu E{Hb, DFF, SS + (size_t)32 * M}; pg8::gemm_phase(lds3, g, S, E); }
    GSYNC();
    { pg8::Gemm g{Hb, W2D, DFF, DFF, DFF}; pg8::StaticOrder S; S.init(M, 1024, DFF, DFF, G, bid); pg8::EpiResid E{nullptr, XN, nullptr, 0.5f}; pg8::gemm_phase(lds3, g, S, E); }
    GSYNC();
    rms_final(XN, p.in[28], p.out, M, gw, NGW);
}

extern "C" void kernel_launch(void* const* d_in, const int* in_sizes, int n_in, void* d_out, int out_size, void* d_ws, size_t ws_size, hipStream_t stream) {
    static int grid = 0; constexpr int LDS_BYTES = 147456;
    if (grid == 0) {
        if (n_in != 29 || out_size != M * DM || ws_size < WS_END) { fprintf(stderr, "kernel_launch: unexpected shapes (n_in %d out %d ws %zu)\n", n_in, out_size, ws_size); grid = -1; return; }
        int dev = 0, cus = 0, per_cu = 0;
        (void)hipGetDevice(&dev); (void)hipDeviceGetAttribute(&cus, hipDeviceAttributeMultiprocessorCount, dev);
        (void)hipFuncSetAttribute((const void*)fwd_megakernel, hipFuncAttributeMaxDynamicSharedMemorySize, LDS_BYTES);
        (void)hipOccupancyMaxActiveBlocksPerMultiprocessor(&per_cu, (const void*)fwd_megakernel, 512, LDS_BYTES);
        if (per_cu < 1) fprintf(stderr, "kernel_launch: occupancy query says %d blocks per CU\n", per_cu);
        (void)hipGetLastError();
        grid = cus > 0 ? cus : 256;
    }
    if (grid < 0) return;
    Params p{};
    for (int i = 0; i < 29; ++i) p.in[i] = (const float*)d_in[i];
    p.out = (float*)d_out; p.ws = (unsigned char*)d_ws;
    void* args[] = {&p};
    hipError_t e = hipLaunchCooperativeKernel((const void*)fwd_megakernel, dim3(grid), dim3(512), args, LDS_BYTES, stream);
    if (e != hipSuccess) fprintf(stderr, "cooperative launch failed: %s (grid %d)\n", hipGetErrorString(e), grid);
}
```

```cpp
#include <hip/hip_runtime.h>
#include <hip/hip_cooperative_groups.h>
#include <cstdio>
#include <cstdint>
namespace cg = cooperative_groups;

namespace pg8 {
#define PG8_LAS __attribute__((address_space(3)))
typedef unsigned short bf16_t;
typedef short bf16x8 __attribute__((ext_vector_type(8)));
typedef float f32x4 __attribute__((ext_vector_type(4)));
typedef unsigned u32x4 __attribute__((ext_vector_type(4)));
typedef unsigned u32x2 __attribute__((ext_vector_type(2)));
constexpr int BM = 256, BK = 64, HALF = 128, HTB = HALF * BK * 2, STAGE_BYTES = 8 * HTB, NXCD = 8, WGM = 8;

__host__ __device__ __forceinline__ int lds_byte(int r, int c) { const int st = (r >> 4) * 2 + (c >> 5), rr = r & 15, cc = c & 31, ob = rr * 64 + cc * 2; return st * 1024 + (ob ^ (((ob >> 9) & 1) << 5)); }
__host__ __device__ __forceinline__ void stage_rc(int b, int& R, int& C) { const int st = b / 1024, sb = b % 1024, swz = sb ^ (((sb >> 9) & 1) << 5); R = (st >> 1) * 16 + swz / 64; C = (st & 1) * 32 + (swz % 64) / 2; }
__host__ __device__ __forceinline__ int perm32(int rho) { const int n = rho >> 4, i = rho & 15; return 8 * (i >> 2) + 4 * n + (i & 3); }

struct Unit { int pm, pn; long aoff, boff; };
struct Gemm { const bf16_t* A; const bf16_t* Bt; int lda, ldb, K; int ksa = 128; };

struct StaticOrder {
    int nM, nN, nwg, G, c, lda, ldb;
    __device__ void init(int M, int N, int lda_, int ldb_, int G_, int c_) { nM = M / BM; nN = N / BM; nwg = nM * nN; G = G_; c = c_; lda = lda_; ldb = ldb_; }
    __device__ bool next(int i, Unit& u) const {
        const long L = (long)i * G + c; if (L >= nwg) return false;
        int wgid = (int)L; { const int q = nwg / NXCD, r = nwg % NXCD, xcd = wgid % NXCD, off = wgid / NXCD; wgid = (xcd < r ? xcd * (q + 1) : r * (q + 1) + (xcd - r) * q) + off; }
        const int nig = WGM * nN, gid = wgid / nig, fm = gid * WGM, gsz = (nM - fm) < WGM ? (nM - fm) : WGM;
        u.pm = fm + ((wgid % nig) % gsz); u.pn = (wgid % nig) / gsz;
        u.aoff = (long)u.pm * BM * lda; u.boff = (long)u.pn * BM * ldb; return true;
    }
};

__device__ __forceinline__ unsigned cvt_pk_bf16(float lo, float hi) { unsigned r; asm volatile("v_cvt_pk_bf16_f32 %0, %1, %2" : "=v"(r) : "v"(lo), "v"(hi)); return r; }
__device__ __forceinline__ float bf2f(unsigned short v) { return __uint_as_float(((unsigned)v) << 16); }
__device__ __forceinline__ float fsigmoid(float x) { return __builtin_amdgcn_rcpf(1.0f + __builtin_amdgcn_exp2f(-1.4426950408889634f * x)); }


__device__ __forceinline__ float row_rstd(const float* ssp, int row) {
    const f32x4* p4 = (const f32x4*)(ssp + (size_t)row * 16); const f32x4 a = p4[0], b = p4[1], c = p4[2], d = p4[3];
    const float t = (((a[0] + a[1]) + (a[2] + a[3])) + ((b[0] + b[1]) + (b[2] + b[3]))) + (((c[0] + c[1]) + (c[2] + c[3])) + ((d[0] + d[1]) + (d[2] + d[3])));
    return __builtin_amdgcn_rsqf(t * (1.f / 1024.f) + 1e-6f);
}
struct EpiSwiglu {
    static constexpr bool PERM = true;
    bf16_t* H; int ldh; const float* ss;
    __device__ __forceinline__ void operator()(const f32x4 (&acc)[2][2][4][2], const Unit& u, int wr, int wc, int fr, int fq) const {
        const int row0 = u.pm * BM + wr * 64 + fr, col0 = u.pn * 128 + wc * 32 + 8 * fq;
#pragma unroll
        for (int ai = 0; ai < 2; ++ai) {
            float rsv[4];
#pragma unroll
            for (int m = 0; m < 4; ++m) rsv[m] = ss ? row_rstd(ss, row0 + ai * HALF + m * 16) : 1.0f;
#pragma unroll
            for (int m = 0; m < 4; ++m) {
                bf16_t* p = H + (size_t)(row0 + ai * HALF + m * 16) * ldh + col0;
                const float rs = rsv[m];
                float h[8];
#pragma unroll
                for (int n = 0; n < 2; ++n)
#pragma unroll
                    for (int e = 0; e < 4; ++e) { const float gv = acc[ai][0][m][n][e] * rs, uv = acc[ai][1][m][n][e] * rs; h[n * 4 + e] = gv * fsigmoid(gv) * uv; }
                u32x4 w; w.x = cvt_pk_bf16(h[0], h[1]); w.y = cvt_pk_bf16(h[2], h[3]); w.z = cvt_pk_bf16(h[4], h[5]); w.w = cvt_pk_bf16(h[6], h[7]);
                *(u32x4*)p = w;
            }
        }
    }
};
struct EpiResid {
    static constexpr bool PERM = true;
    const float* basef; bf16_t* xs; float* ss; float alpha;
    __device__ __forceinline__ void operator()(const f32x4 (&acc)[2][2][4][2], const Unit& u, int wr, int wc, int fr, int fq) const {
        const int col0 = u.pn * BM + wc * 32 + 8 * fq;
#pragma unroll
        for (int ai = 0; ai < 2; ++ai)
#pragma unroll
        for (int mh = 0; mh < 2; ++mh) {
            f32x4 bf[2][2][2]; u32x4 bh[2][2];
#pragma unroll
            for (int m2 = 0; m2 < 2; ++m2)
#pragma unroll
                for (int bj = 0; bj < 2; ++bj) {
                    const size_t off = (size_t)(u.pm * BM + ai * HALF + wr * 64 + (2 * mh + m2) * 16 + fr) * 1024 + col0 + bj * HALF;
                    if (!basef) bh[m2][bj] = *(const u32x4*)(xs + off);
                }
#pragma unroll
            for (int m2 = 0; m2 < 2; ++m2) {
                const int m = 2 * mh + m2;
                const int row = u.pm * BM + ai * HALF + wr * 64 + m * 16 + fr; float sq = 0.f;
                if (basef) {
#pragma unroll
                    for (int bj = 0; bj < 2; ++bj) { const size_t off = (size_t)row * 1024 + col0 + bj * HALF; bf[m2][bj][0] = *(const f32x4*)(basef + off); bf[m2][bj][1] = *(const f32x4*)(basef + off + 4); }
                }
#pragma unroll
                for (int bj = 0; bj < 2; ++bj) {
                    const size_t off = (size_t)row * 1024 + col0 + bj * HALF;
                    float bv[8];
                    if (basef) { const f32x4 b0 = bf[m2][bj][0], b1 = bf[m2][bj][1]; bv[0] = b0[0]; bv[1] = b0[1]; bv[2] = b0[2]; bv[3] = b0[3]; bv[4] = b1[0]; bv[5] = b1[1]; bv[6] = b1[2]; bv[7] = b1[3]; }
                    else { const u32x4 gw = bh[m2][bj];
                        bv[0] = __uint_as_float(gw.x << 16); bv[1] = __uint_as_float(gw.x & 0xffff0000u); bv[2] = __uint_as_float(gw.y << 16); bv[3] = __uint_as_float(gw.y & 0xffff0000u);
                        bv[4] = __uint_as_float(gw.z << 16); bv[5] = __uint_as_float(gw.z & 0xffff0000u); bv[6] = __uint_as_float(gw.w << 16); bv[7] = __uint_as_float(gw.w & 0xffff0000u); }
                    float y[8];
#pragma unroll
                    for (int e = 0; e < 4; ++e) { y[e] = bv[e] + alpha * acc[ai][bj][m][0][e]; y[4 + e] = bv[4 + e] + alpha * acc[ai][bj][m][1][e]; }
                    u32x4 w; w.x = cvt_pk_bf16(y[0], y[1]); w.y = cvt_pk_bf16(y[2], y[3]); w.z = cvt_pk_bf16(y[4], y[5]); w.w = cvt_pk_bf16(y[6], y[7]);
                    *(u32x4*)(xs + off) = w;
                    if (ss) sq += ((y[0] * y[0] + y[1] * y[1]) + (y[2] * y[2] + y[3] * y[3])) + ((y[4] * y[4] + y[5] * y[5]) + (y[6] * y[6] + y[7] * y[7]));
                }
                if (ss) { sq += __shfl_xor(sq, 16); sq += __shfl_xor(sq, 32); if (fq == 0) ss[(size_t)row * 16 + u.pn * 4 + wc] = sq; }
            }
        }
    }
};
struct EpiBf16 {
    static constexpr bool PERM = true;
    bf16_t* O0; int ld0; int split_pn; bf16_t* O1; int ld1; int act0, act1; const float* rowscale; const float* ss; const float* cbias;
    __device__ __forceinline__ void operator()(const f32x4 (&acc)[2][2][4][2], const Unit& u, int wr, int wc, int fr, int fq) const {
        bf16_t* O = O0; int ld = ld0, colt = u.pn * BM, act = act0;
        if (u.pn >= split_pn) { O = O1; ld = ld1; colt = (u.pn - split_pn) * BM; act = act1; }
        const int row0 = u.pm * BM + wr * 64 + fr, col0 = colt + wc * 32 + 8 * fq;
        float rsv[2][4];
#pragma unroll
        for (int ai = 0; ai < 2; ++ai)
#pragma unroll
            for (int m = 0; m < 4; ++m) {
                const int row = row0 + ai * HALF + m * 16;
                float rs = 1.0f; if (rowscale) { const f32x4 lp = *(const f32x4*)(rowscale + ((size_t)row * 4 + u.pn) * 4); rs = __builtin_amdgcn_rcpf((lp[0] + lp[1]) + (lp[2] + lp[3])); }
                if (ss) rs = row_rstd(ss, row);
                rsv[ai][m] = rs;
            }
#pragma unroll
        for (int ai = 0; ai < 2; ++ai)
#pragma unroll
            for (int m = 0; m < 4; ++m) {
                const int row = row0 + ai * HALF + m * 16;
                const float rs = rsv[ai][m];
                bf16_t* rowp = O + (size_t)row * ld + col0;
#pragma unroll
                for (int bj = 0; bj < 2; ++bj) {
                    float h[8];
#pragma unroll
                    for (int n = 0; n < 2; ++n)
#pragma unroll
                        for (int e = 0; e < 4; ++e) {
                            float x = acc[ai][bj][m][n][e] * rs;
                            if (cbias) x += cbias[(u.pm >> 5) * 256 + (col0 - colt) + bj * HALF + n * 4 + e];
                            if (act == 1) x = fsigmoid(x);
                            else if (act == 2) { const float z = 1.5957691216057308f * (x + 0.044715f * x * x * x); x = x * fsigmoid(z); }
                            h[n * 4 + e] = x;
                        }
                    u32x4 w; w.x = cvt_pk_bf16(h[0], h[1]); w.y = cvt_pk_bf16(h[2], h[3]); w.z = cvt_pk_bf16(h[4], h[5]); w.w = cvt_pk_bf16(h[6], h[7]);
                    *(u32x4*)(rowp + bj * HALF) = w;
                }
            }
    }
};
struct EpiCmp2 {
    static constexpr bool PERM = true;
    bf16_t* KC; bf16_t* VCT;
    __device__ __forceinline__ void operator()(const f32x4 (&acc)[2][2][4][2], const Unit& u, int wr, int wc, int fr, int fq) const {
        if (wc >= 2) return;
        const int col0 = wc * 32 + 8 * fq;
#pragma unroll
        for (int ai = 0; ai < 2; ++ai)
#pragma unroll
            for (int m = 0; m < 4; ++m) {
                const int row = u.pm * BM + ai * HALF + wr * 64 + m * 16 + fr;
                if (u.pm < 32) {
                    u32x4 w; w.x = cvt_pk_bf16(acc[ai][0][m][0][0], acc[ai][0][m][0][1]); w.y = cvt_pk_bf16(acc[ai][0][m][0][2], acc[ai][0][m][0][3]);
                    w.z = cvt_pk_bf16(acc[ai][0][m][1][0], acc[ai][0][m][1][1]); w.w = cvt_pk_bf16(acc[ai][0][m][1][2], acc[ai][0][m][1][3]);
                    *(u32x4*)(KC + (size_t)row * 64 + col0) = w;
                } else {
                    const int r2 = row - 8192, bg = r2 >> 9, n = r2 & 511;
#pragma unroll
                    for (int nn = 0; nn < 2; ++nn)
#pragma unroll
                        for (int e = 0; e < 4; ++e) VCT[(size_t)(bg * 64 + col0 + nn * 4 + e) * 512 + n] = (bf16_t)(cvt_pk_bf16(acc[ai][0][m][nn][e], 0.f) & 0xffffu);
                }
            }
    }
};
__device__ __forceinline__ void unpack8(float (&gv)[8], const u32x4& gw) {
    gv[0] = __uint_as_float(gw.x << 16); gv[1] = __uint_as_float(gw.x & 0xffff0000u); gv[2] = __uint_as_float(gw.y << 16); gv[3] = __uint_as_float(gw.y & 0xffff0000u);
    gv[4] = __uint_as_float(gw.z << 16); gv[5] = __uint_as_float(gw.z & 0xffff0000u); gv[6] = __uint_as_float(gw.w << 16); gv[7] = __uint_as_float(gw.w & 0xffff0000u);
}
struct EpiGate {
    static constexpr bool PERM = true, HOOK = true;
    const bf16_t* gate; int ldg; bf16_t* MO;
    __device__ __forceinline__ void hook(f32x4 (&acc)[2][2][4][2], const Unit& u, int wr, int wc, int fr, int fq) const {
        int row0 = u.pm * BM + wr * 64 + fr, col0 = u.pn * BM + wc * 32 + 8 * fq;
        asm volatile("" : "+v"(row0), "+v"(col0));
#pragma unroll
        for (int ai = 0; ai < 2; ++ai)
#pragma unroll
            for (int mh = 0; mh < 2; ++mh) {
                u32x4 ra[2][2], rb[2][2];
#pragma unroll
                for (int m2 = 0; m2 < 2; ++m2)
#pragma unroll
                    for (int bj = 0; bj < 2; ++bj) {
                        const unsigned goff = ((unsigned)(row0 + ai * HALF + (2 * mh + m2) * 16) * (unsigned)ldg + (unsigned)(col0 + bj * HALF)) * 2u;
                        ra[m2][bj] = *(const u32x4*)((const char*)gate + goff); rb[m2][bj] = *(const u32x4*)((const char*)gate + 2048 + goff);
                    }
#pragma unroll
                for (int m2 = 0; m2 < 2; ++m2)
#pragma unroll
                    for (int bj = 0; bj < 2; ++bj) {
                        const int m = 2 * mh + m2; float ga[8], gb[8]; unpack8(ga, ra[m2][bj]); unpack8(gb, rb[m2][bj]);
#pragma unroll
                        for (int e = 0; e < 4; ++e) { acc[ai][bj][m][0][e] *= ga[e] * __builtin_amdgcn_rcpf(gb[e]); acc[ai][bj][m][1][e] *= ga[4 + e] * __builtin_amdgcn_rcpf(gb[4 + e]); }
                    }
                asm volatile("" ::: "memory");
            }
    }
    __device__ __forceinline__ void operator()(const f32x4 (&acc)[2][2][4][2], const Unit& u, int wr, int wc, int fr, int fq) const {
        const int row0 = u.pm * BM + wr * 64 + fr, col0 = u.pn * BM + wc * 32 + 8 * fq;
#pragma unroll
        for (int ai = 0; ai < 2; ++ai) {
            u32x4 rb[4][2];
#pragma unroll
            for (int m = 0; m < 4; ++m)
#pragma unroll
                for (int bj = 0; bj < 2; ++bj) rb[m][bj] = *(const u32x4*)((const char*)gate + 2048 + ((unsigned)(row0 + ai * HALF + m * 16) * (unsigned)ldg + (unsigned)(col0 + bj * HALF)) * 2u);
#pragma unroll
            for (int m = 0; m < 4; ++m)
#pragma unroll
                for (int bj = 0; bj < 2; ++bj) {
                    const int row = row0 + ai * HALF + m * 16, col = col0 + bj * HALF;
                    float gb[8]; unpack8(gb, rb[m][bj]);
                    const f32x4 a0 = acc[ai][bj][m][0], a1 = acc[ai][bj][m][1];
                    u32x4 w; w.x = cvt_pk_bf16(a0[0] * gb[0], a0[1] * gb[1]); w.y = cvt_pk_bf16(a0[2] * gb[2], a0[3] * gb[3]); w.z = cvt_pk_bf16(a1[0] * gb[4], a1[1] * gb[5]); w.w = cvt_pk_bf16(a1[2] * gb[6], a1[3] * gb[7]);
                    *(u32x4*)(MO + (size_t)row * 1024 + col) = w;
                }
        }
    }
};
struct EpiXS {
    static constexpr bool PERM = true;
    bf16_t* P; float* L;
    __device__ __forceinline__ void operator()(const f32x4 (&acc)[2][2][4][2], const Unit& u, int wr, int wc, int fr, int fq) const {
        const int row0 = u.pm * BM + wr * 64 + fr, col0 = u.pn * BM + wc * 32 + 8 * fq;
#pragma unroll
        for (int ai = 0; ai < 2; ++ai)
#pragma unroll
            for (int m = 0; m < 4; ++m) {
                const int row = row0 + ai * HALF + m * 16; float rsum = 0.f;
#pragma unroll
                for (int bj = 0; bj < 2; ++bj) {
                    float h[8];
#pragma unroll
                    for (int n = 0; n < 2; ++n)
#pragma unroll
                        for (int e = 0; e < 4; ++e) { const float pe = __builtin_amdgcn_exp2f(fminf(acc[ai][bj][m][n][e], 100.f)); h[n * 4 + e] = pe; rsum += pe; }
                    u32x4 w; w.x = cvt_pk_bf16(h[0], h[1]); w.y = cvt_pk_bf16(h[2], h[3]); w.z = cvt_pk_bf16(h[4], h[5]); w.w = cvt_pk_bf16(h[6], h[7]);
                    *(u32x4*)(P + (size_t)row * 1024 + col0 + bj * HALF) = w;
                }
                rsum += __shfl_xor(rsum, 16); rsum += __shfl_xor(rsum, 32);
                if (fq == 0) L[((size_t)row * 4 + u.pn) * 4 + wc] = rsum;
            }
    }
};

template <class E, class = void> struct epi_has_hook { static constexpr bool value = false; };
template <class E> struct epi_has_hook<E, decltype((void)E::HOOK)> { static constexpr bool value = E::HOOK; };
template <class Epi, class Sched>
__device__ __forceinline__ void gemm_phase(PG8_LAS unsigned char* lds, const Gemm g, const Sched& S, const Epi& E) {
    int tid = threadIdx.x; asm volatile("" : "+v"(tid));
    const int wid = __builtin_amdgcn_readfirstlane(tid >> 6), lane = tid & 63, wr = wid >> 2, wc = wid & 3, fr = lane & 15, fq = lane >> 4;
    const int K = g.K, nt = K / BK;
    unsigned voffA[2], voffB[2];
#pragma unroll
    for (int i = 0; i < 2; ++i) { int R, C; stage_rc(tid * 16 + i * 8192, R, C); const int Rb = Epi::PERM ? ((R & ~31) + perm32(R & 31)) : R;
        voffA[i] = (unsigned)(R * g.lda + C) * 2u; voffB[i] = (unsigned)(Rb * g.ldb + C) * 2u; }
    const size_t kstep = (size_t)(BK * 2), kstepA = (size_t)g.ksa;
    const size_t hstepA = (size_t)HALF * g.lda * 2, hstepB = (size_t)HALF * g.ldb * 2;
    const unsigned ldsw = (unsigned)wid * 1024u;
    const int aoff = lds_byte(wr * 64 + fr, fq * 8), boff = lds_byte(wc * 32 + fr, fq * 8);
#define PG8_SA(b, h) (((b) * 2 + (h)) * HTB)
#define PG8_SB(b, h) ((4 + (b) * 2 + (h)) * HTB)
#define PG8_STAGE(bufoff, gbase, voff) do { _Pragma("unroll") for (int _i = 0; _i < 2; ++_i) \
        __builtin_amdgcn_global_load_lds((const unsigned*)((const char*)(gbase) + (voff)[_i]), (PG8_LAS unsigned*)(lds + (bufoff) + ldsw + _i * 8192), 16, 0, 0); } while (0)
#define PG8_LDA(dst, b, h) do { _Pragma("unroll") for (int m = 0; m < 4; ++m) _Pragma("unroll") for (int k = 0; k < 2; ++k) dst[m][k] = *(const PG8_LAS bf16x8*)(lds + PG8_SA(b, h) + aoff + m * 2048 + k * 1024); } while (0)
#define PG8_LDB(dst, b, h) do { _Pragma("unroll") for (int n = 0; n < 2; ++n) _Pragma("unroll") for (int k = 0; k < 2; ++k) dst[n][k] = *(const PG8_LAS bf16x8*)(lds + PG8_SB(b, h) + boff + n * 2048 + k * 1024); } while (0)
#define PG8_MMA(ai, bj, At, Bt) do { __builtin_amdgcn_s_setprio(1); _Pragma("unroll") for (int m = 0; m < 4; ++m) _Pragma("unroll") for (int n = 0; n < 2; ++n) _Pragma("unroll") for (int k = 0; k < 2; ++k) \
        acc[ai][bj][m][n] = __builtin_amdgcn_mfma_f32_16x16x32_bf16(Bt[n][k], At[m][k], acc[ai][bj][m][n], 0, 0, 0); __builtin_amdgcn_s_setprio(0); } while (0)
#define PG8_WAIT_V(n) asm volatile("s_waitcnt vmcnt(" #n ")" ::: "memory")
#define PG8_WAIT_L(n) asm volatile("s_waitcnt lgkmcnt(" #n ")" ::: "memory")
#define PG8_BAR __builtin_amdgcn_s_barrier()
#define PG8_SCHED __builtin_amdgcn_sched_barrier(0)
    Unit cur, nxt; int ui = 0;
    if (!S.next(0, cur)) return;
    f32x4 acc[2][2][4][2];
#pragma unroll
    for (int a = 0; a < 2; ++a)
#pragma unroll
        for (int b = 0; b < 2; ++b)
#pragma unroll
            for (int m = 0; m < 4; ++m)
#pragma unroll
                for (int n = 0; n < 2; ++n) acc[a][b][m][n] = (f32x4){0.f, 0.f, 0.f, 0.f};
    bf16x8 At[4][2], B0[2][2], B1[2][2];
    const char* cA = (const char*)g.A + (size_t)cur.aoff * 2; const char* cB = (const char*)g.Bt + (size_t)cur.boff * 2;
    PG8_STAGE(PG8_SB(0, 0), cB, voffB); PG8_STAGE(PG8_SB(0, 1), cB + hstepB, voffB); PG8_STAGE(PG8_SA(0, 0), cA, voffA); PG8_STAGE(PG8_SA(0, 1), cA + hstepA, voffA);
    if (wr == 1) PG8_BAR;
    PG8_WAIT_V(2); PG8_BAR;
    PG8_STAGE(PG8_SB(1, 0), cB + kstep, voffB); PG8_STAGE(PG8_SA(1, 0), cA + kstepA, voffA); PG8_STAGE(PG8_SB(1, 1), cB + hstepB + kstep, voffB);
    PG8_WAIT_V(6); PG8_BAR;
    for (;;) {
        const bool has_next = S.next(ui + 1, nxt);
        const char* nA = has_next ? (const char*)g.A + (size_t)nxt.aoff * 2 : cA; const char* nB = has_next ? (const char*)g.Bt + (size_t)nxt.boff * 2 : cB;
#pragma nounroll
        for (int t = 0; t < nt; t += 2) {
            const bool last = (t == nt - 2);
            const char* a1 = cA + (size_t)(t + 1) * kstepA;
            const char* a2 = last ? nA : cA + (size_t)(t + 2) * kstepA; const char* b2 = last ? nB : cB + (size_t)(t + 2) * kstep;
            const char* a3 = a2 + kstepA; const char* b3 = b2 + kstep;
            if constexpr (epi_has_hook<Epi>::value) { if (t == nt / 2) E.hook(acc, cur, wr, wc, fr, fq); }
            PG8_LDB(B0, 0, 0); PG8_LDB(B1, 0, 1); PG8_SCHED; PG8_LDA(At, 0, 0); PG8_STAGE(PG8_SA(1, 1), a1 + hstepA, voffA);
            PG8_WAIT_V(8); PG8_WAIT_L(0); PG8_BAR; PG8_MMA(0, 0, At, B0); PG8_MMA(0, 1, At, B1); PG8_BAR; PG8_SCHED;
            PG8_LDA(At, 0, 1); PG8_STAGE(PG8_SB(0, 0), b2, voffB); PG8_STAGE(PG8_SB(0, 1), b2 + hstepB, voffB); PG8_STAGE(PG8_SA(0, 0), a2, voffA);
            PG8_WAIT_V(8); PG8_WAIT_L(0); PG8_BAR; PG8_MMA(1, 0, At, B0); PG8_MMA(1, 1, At, B1); PG8_BAR; PG8_SCHED;
            PG8_LDB(B0, 1, 0); PG8_LDB(B1, 1, 1); PG8_SCHED; PG8_LDA(At, 1, 0); PG8_STAGE(PG8_SA(0, 1), a2 + hstepA, voffA);
            PG8_WAIT_V(8); PG8_WAIT_L(0); PG8_BAR; PG8_MMA(0, 0, At, B0); PG8_MMA(0, 1, At, B1); PG8_BAR; PG8_SCHED;
            PG8_LDA(At, 1, 1); PG8_STAGE(PG8_SB(1, 0), b3, voffB); PG8_STAGE(PG8_SB(1, 1), b3 + hstepB, voffB); PG8_STAGE(PG8_SA(1, 0), a3, voffA);
            PG8_WAIT_V(8); PG8_WAIT_L(0); PG8_BAR; PG8_MMA(1, 0, At, B0); PG8_MMA(1, 1, At, B1); PG8_BAR; PG8_SCHED;
        }
        if (wr == 0) PG8_BAR;
        E(acc, cur, wr, wc, fr, fq);
        if (!has_next) break;
#pragma unroll
        for (int a = 0; a < 2; ++a)
#pragma unroll
            for (int b = 0; b < 2; ++b)
#pragma unroll
                for (int m = 0; m < 4; ++m)
#pragma unroll
                    for (int n = 0; n < 2; ++n) acc[a][b][m][n] = (f32x4){0.f, 0.f, 0.f, 0.f};
        cur = nxt; cA = nA; cB = nB; ++ui;
        if (wr == 1) PG8_BAR;
    }
    PG8_WAIT_V(0);
    PG8_BAR;
#undef PG8_SA
#undef PG8_SB
#undef PG8_STAGE
#undef PG8_LDA
#undef PG8_LDB
#undef PG8_MMA
#undef PG8_WAIT_V
#undef PG8_WAIT_L
#undef PG8_BAR
#undef PG8_SCHED
}
}

using pg8::bf16_t; using pg8::bf16x8; using pg8::f32x4; using pg8::u32x4; using pg8::u32x2;
using pg8::cvt_pk_bf16; using pg8::bf2f; using pg8::fsigmoid;

constexpr int M = 65536, DM = 1024, DFF = 2816, SEQ = 8192;
constexpr size_t MiB = 1u << 20;
constexpr size_t WS_L = 0, WS_CB = 64 * 1024;
constexpr size_t WS_W1GU = 1 * MiB, WS_W1D = 12 * MiB, WS_W2GU = 18 * MiB, WS_W2D = 29 * MiB, WS_WIN = 35 * MiB, WS_WC1 = 44 * MiB, WS_WC2 = 46 * MiB,
                 WS_WUA = 47 * MiB, WS_WUB = 48 * MiB, WS_WOUT = 49 * MiB, WS_WXQ = 51 * MiB, WS_WXKV = 53 * MiB, WS_WXO = 57 * MiB;
constexpr size_t WS_OA = 65 * MiB, WS_XN = 321 * MiB, WS_R = 449 * MiB;
constexpr size_t WS_H = WS_R, WS_PQ = WS_R, WS_PG = 737 * MiB, WS_MERGED = WS_R, WS_QX = WS_R, WS_PX = 577 * MiB, WS_OX = 705 * MiB;
constexpr size_t WS_MEMN = 993 * MiB, WS_KM = 997 * MiB, WS_VMT = 1001 * MiB, WS_SS = 1005 * MiB, WS_LP = 1017 * MiB, WS_END = 1021 * MiB;
constexpr size_t DO_ACMP = 0, DO_HC = 64 * MiB, DO_KC = 72 * MiB, DO_VCT = 73 * MiB, DO_KVS = 80 * MiB, DO_KVW = 112 * MiB, DO_KVB = 144 * MiB, DO_T = 0;
constexpr int PQ_LD = 2304, PG_LD = 2048;
constexpr int BAR_LDS_OFF = 147456 - 16;
constexpr size_t BAR_BYTES = 16384;
constexpr float LOG2E = 1.4426950408889634f;

__device__ __forceinline__ int t5_bucket(int d) {
    if (d < 16) return d;
    int bk = 16;
    bk += d >= 19; bk += d >= 21; bk += d >= 24; bk += d >= 27; bk += d >= 31; bk += d >= 35; bk += d >= 40; bk += d >= 46;
    bk += d >= 52; bk += d >= 59; bk += d >= 67; bk += d >= 77; bk += d >= 87; bk += d >= 99; bk += d >= 113;
    return bk;
}

#define PROBE_ATT_A 1
#define REP_CMP 1
#define REP_TOPK 1
#define REP_SEL 1
#define REP_WIN 1
#define PROBE_ATT_B 1
struct Params { const float* in[29]; float* out; unsigned char* ws; };

__device__ __forceinline__ float wave_sum(float v) {
#pragma unroll
    for (int o = 1; o < 64; o <<= 1) v += __shfl_xor(v, o);
    return v;
}
__device__ __forceinline__ void conv_item(const float* W, int K, int N, bf16_t* WT, int ldd, int kofs, int kind, int roff, const float* gk, float* scr, int item, int lane) {
    const int nblk = (N + 31) / 32, kb = item / nblk, nb = item % nblk, k0 = 64 * kb, n0 = 32 * nb;
    const int nr = n0 + (lane & 31);
    float wv[32];
#pragma unroll
    for (int i = 0; i < 32; ++i) { const int kk = 2 * i + (lane >> 5); wv[i] = (nr < N) ? W[(size_t)(k0 + kk) * N + nr] : 0.f; }
#pragma unroll
    for (int i = 0; i < 32; ++i) { const int kk = 2 * i + (lane >> 5); scr[kk * 33 + (lane & 31)] = wv[i]; }
    asm volatile("s_waitcnt lgkmcnt(0)" ::: "memory");
    const int c = lane & 7;
#pragma unroll
    for (int j = 0; j < 4; ++j) {
        const int nl = (lane >> 3) + 8 * j, n = n0 + nl; const float* s = scr + (8 * c) * 33 + nl;
        int dr = n + roff; float sc = 1.0f;
        if (kind == 1) dr = (n >> 7) * 256 + (n & 127);
        else if (kind == 2) dr = (n >> 7) * 256 + 128 + (n & 127);
        else if (kind == 3) { dr = n < 2072 ? n : n + 232; if (n < 512 || (n >= 1304 && n < 1816)) sc = 0.125f * LOG2E; }
        else if (kind == 4) sc = 0.0625f * LOG2E;
        f32x4 g0 = (f32x4){sc, sc, sc, sc}, g1 = g0;
        if (gk) { g0 = *(const f32x4*)(gk + k0 + 8 * c) * sc; g1 = *(const f32x4*)(gk + k0 + 8 * c + 4) * sc; }
        u32x4 o; o.x = cvt_pk_bf16(s[0 * 33] * g0[0], s[1 * 33] * g0[1]); o.y = cvt_pk_bf16(s[2 * 33] * g0[2], s[3 * 33] * g0[3]); o.z = cvt_pk_bf16(s[4 * 33] * g1[0], s[5 * 33] * g1[1]); o.w = cvt_pk_bf16(s[6 * 33] * g1[2], s[7 * 33] * g1[3]);
        if (n < N) *(u32x4*)(WT + (size_t)dr * ldd + kofs + k0 + 8 * c) = o;
    }
    asm volatile("s_waitcnt lgkmcnt(0)" ::: "memory");
}
__device__ __forceinline__ void rms_row(const float* xrow, const float* g, bf16_t* orow, float* frow, int lane) {
    const f32x4* xr = (const f32x4*)xrow + lane; const f32x4* gr = (const f32x4*)g + lane;
    f32x4 v[4]; float s = 0.f;
#pragma unroll
    for (int j = 0; j < 4; ++j) { v[j] = xr[64 * j]; s += (v[j].x * v[j].x + v[j].y * v[j].y) + (v[j].z * v[j].z + v[j].w * v[j].w); }
    const float rstd = 1.0f / sqrtf(wave_sum(s) * (1.f / 1024.f) + 1e-6f);
#pragma unroll
    for (int j = 0; j < 4; ++j) {
        const f32x4 gg = gr[64 * j]; const f32x4 y = v[j] * rstd * gg;
        if (orow) { u32x2 w; w.x = cvt_pk_bf16(y.x, y.y); w.y = cvt_pk_bf16(y.z, y.w); *((u32x2*)orow + lane + 64 * j) = w; }
        else *((f32x4*)frow + lane + 64 * j) = y;
    }
}
__device__ __forceinline__ void rms_row_bf16(const bf16_t* xrow, const float* g, float* frow, int lane) {
    float v[2][8]; float s = 0.f;
#pragma unroll
    for (int j = 0; j < 2; ++j) { const u32x4 gw = *((const u32x4*)xrow + lane + 64 * j);
        v[j][0] = __uint_as_float(gw.x << 16); v[j][1] = __uint_as_float(gw.x & 0xffff0000u); v[j][2] = __uint_as_float(gw.y << 16); v[j][3] = __uint_as_float(gw.y & 0xffff0000u);
        v[j][4] = __uint_as_float(gw.z << 16); v[j][5] = __uint_as_float(gw.z & 0xffff0000u); v[j][6] = __uint_as_float(gw.w << 16); v[j][7] = __uint_as_float(gw.w & 0xffff0000u);
#pragma unroll
        for (int e = 0; e < 8; ++e) s += v[j][e] * v[j][e]; }
    const float rstd = 1.0f / sqrtf(wave_sum(s) * (1.f / 1024.f) + 1e-6f);
#pragma unroll
    for (int j = 0; j < 2; ++j) {
        const f32x4 g0 = *((const f32x4*)g + 2 * (lane + 64 * j)), g1 = *((const f32x4*)g + 2 * (lane + 64 * j) + 1);
        *((f32x4*)frow + 2 * (lane + 64 * j)) = (f32x4){v[j][0] * rstd * g0[0], v[j][1] * rstd * g0[1], v[j][2] * rstd * g0[2], v[j][3] * rstd * g0[3]};
        *((f32x4*)frow + 2 * (lane + 64 * j) + 1) = (f32x4){v[j][4] * rstd * g1[0], v[j][5] * rstd * g1[1], v[j][6] * rstd * g1[2], v[j][7] * rstd * g1[3]};
    }
}
__device__ __forceinline__ void rms_pass(const float* X, const float* g, bf16_t* O, float* F, int rows, int gw, int NGW) {
    int tid_ = threadIdx.x; asm volatile("" : "+v"(tid_)); const int lane = tid_ & 63;
    const f32x4* gr = (const f32x4*)g + lane;
    for (int m = gw; m < rows; m += 2 * NGW) {
        const bool two = (m + NGW) < rows; const int m1 = two ? m + NGW : m;
        const f32x4* x0 = (const f32x4*)(X + (size_t)m * 1024) + lane; const f32x4* x1 = (const f32x4*)(X + (size_t)m1 * 1024) + lane;
        f32x4 v0[4], v1[4]; float s0 = 0.f, s1 = 0.f;
#pragma unroll
        for (int j = 0; j < 4; ++j) { v0[j] = x0[64 * j]; v1[j] = x1[64 * j]; }
#pragma unroll
        for (int j = 0; j < 4; ++j) { s0 += (v0[j].x * v0[j].x + v0[j].y * v0[j].y) + (v0[j].z * v0[j].z + v0[j].w * v0[j].w); s1 += (v1[j].x * v1[j].x + v1[j].y * v1[j].y) + (v1[j].z * v1[j].z + v1[j].w * v1[j].w); }
        const float r0 = 1.0f / sqrtf(wave_sum(s0) * (1.f / 1024.f) + 1e-6f), r1 = 1.0f / sqrtf(wave_sum(s1) * (1.f / 1024.f) + 1e-6f);
#pragma unroll
        for (int j = 0; j < 4; ++j) {
            const f32x4 gg = gr[64 * j]; const f32x4 y0 = v0[j] * r0 * gg, y1 = v1[j] * r1 * gg;
            u32x2 w0, w1; w0.x = cvt_pk_bf16(y0.x, y0.y); w0.y = cvt_pk_bf16(y0.z, y0.w); w1.x = cvt_pk_bf16(y1.x, y1.y); w1.y = cvt_pk_bf16(y1.z, y1.w);
            *((u32x2*)(O + (size_t)m * 1024) + lane + 64 * j) = w0;
            if (two) *((u32x2*)(O + (size_t)m1 * 1024) + lane + 64 * j) = w1;
        }
    }
}
__device__ __forceinline__ void rms_final(const bf16_t* X, const float* g, float* out, int rows, int gw, int NGW) {
    int tid_ = threadIdx.x; asm volatile("" : "+v"(tid_)); const int lane = tid_ & 63;
    for (int m = gw; m < rows; m += 4 * NGW) {
        u32x4 raw[4][2];
#pragma unroll
        for (int k = 0; k < 4; ++k) { const int mk = (m + k * NGW) < rows ? m + k * NGW : m;
#pragma unroll
            for (int j = 0; j < 2; ++j) raw[k][j] = *((const u32x4*)(X + (size_t)mk * 1024) + lane + 64 * j); }
#pragma unroll
        for (int k = 0; k < 4; ++k) {
            float v[2][8]; float sq = 0.f;
#pragma unroll
            for (int j = 0; j < 2; ++j) { const u32x4 gw4 = raw[k][j];
                v[j][0] = __uint_as_float(gw4.x << 16); v[j][1] = __uint_as_float(gw4.x & 0xffff0000u); v[j][2] = __uint_as_float(gw4.y << 16); v[j][3] = __uint_as_float(gw4.y & 0xffff0000u);
                v[j][4] = __uint_as_float(gw4.z << 16); v[j][5] = __uint_as_float(gw4.z & 0xffff0000u); v[j][6] = __uint_as_float(gw4.w << 16); v[j][7] = __uint_as_float(gw4.w & 0xffff0000u);
#pragma unroll
                for (int e = 0; e < 8; ++e) sq += v[j][e] * v[j][e]; }
            const float rstd = 1.0f / sqrtf(wave_sum(sq) * (1.f / 1024.f) + 1e-6f);
            if ((m + k * NGW) < rows) {
                float* frow = out + (size_t)(m + k * NGW) * 1024;
#pragma unroll
                for (int j = 0; j < 2; ++j) {
                    const f32x4 g0 = *((const f32x4*)g + 2 * (lane + 64 * j)), g1 = *((const f32x4*)g + 2 * (lane + 64 * j) + 1);
                    *((f32x4*)frow + 2 * (lane + 64 * j)) = (f32x4){v[j][0] * rstd * g0[0], v[j][1] * rstd * g0[1], v[j][2] * rstd * g0[2], v[j][3] * rstd * g0[3]};
                    *((f32x4*)frow + 2 * (lane + 64 * j) + 1) = (f32x4){v[j][4] * rstd * g1[0], v[j][5] * rstd * g1[1], v[j][6] * rstd * g1[2], v[j][7] * rstd * g1[3]};
                }
            }
        }
    }
}

namespace att {
constexpr int SLOTB = 16384, NSLOT = 4;
constexpr int OFF_RING = 0, OFF_BT = NSLOT * SLOTB, OFF_SEL = OFF_BT + 129 * 16 * 4 + 192, OFF_IMP = OFF_SEL + 64 * 4 * 4, IMP_LD = 129, OFF_STASH = OFF_IMP, ATT_LDS = OFF_STASH + 32 * 512 * 4;
static_assert(OFF_IMP % 16 == 0 && 64 * IMP_LD * 4 <= 32 * 512 * 4 && ATT_LDS <= 147456, "attention LDS map");
struct Args { const bf16_t* PQ; const bf16_t* KC; const bf16_t* VCT; const bf16_t* KVS; const bf16_t* KVW; const bf16_t* KVB; bf16_t* OA; bf16_t* OB; const float* sinks; };

__device__ __forceinline__ int prow(int f, int r) { return 32 * (f >> 1) + 8 * (r >> 2) + 4 * (f & 1) + (r & 3); }
__device__ __forceinline__ int swz(int R) { return (R & 2) | ((R & 8) >> 1); }
__device__ __forceinline__ unsigned src_off(int w, int lane, int ldB) { const int R = 8 * w + (lane >> 3), cch = (lane & 7) ^ swz(R); return (unsigned)(R * ldB + cch * 16); }
__device__ __forceinline__ void glds16(const void* gsrc, unsigned lds_dst) { unsigned keep;
    asm volatile("s_mov_b32 %0, m0\n\ts_mov_b32 m0, %2\n\ts_nop 0\n\tglobal_load_lds_dwordx4 %1, off\n\ts_mov_b32 m0, %0" : "=&s"(keep) : "v"(gsrc), "s"(lds_dst) : "memory"); }
__device__ __forceinline__ void dma_block(PG8_LAS unsigned char* lds3, int slot, int wu, const unsigned char* Kblk, unsigned koff, const unsigned char* Vblk, unsigned voff) {
    const unsigned base = (unsigned)(__UINTPTR_TYPE__)lds3 + OFF_RING + slot * SLOTB + wu * 1024;
    glds16(Kblk + koff, (unsigned)__builtin_amdgcn_readfirstlane(base));
    glds16(Vblk + voff, (unsigned)__builtin_amdgcn_readfirstlane(base + 8192));
}
__device__ __forceinline__ void ring_wait_bar(int young) {
    if (young >= 2) asm volatile("s_waitcnt vmcnt(4)" ::: "memory"); else if (young == 1) asm volatile("s_waitcnt vmcnt(2)" ::: "memory"); else asm volatile("s_waitcnt vmcnt(0)" ::: "memory");
    asm volatile("s_waitcnt lgkmcnt(0)" ::: "memory");
    __builtin_amdgcn_s_barrier();
    asm volatile("" ::: "memory");
}
__device__ __forceinline__ void load_kfrags(bf16x8 (&kf)[4][2], const unsigned char* Ks, int r, int fq) {
#pragma unroll
    for (int f = 0; f < 4; ++f)
#pragma unroll
        for (int dc = 0; dc < 2; ++dc) { const int R = prow(f, r); kf[f][dc] = *(const bf16x8*)(Ks + R * 128 + (((4 * dc + fq) ^ swz(R)) << 4)); }
}
__device__ __forceinline__ void qk(f32x4 (&s)[4], const bf16x8 (&kf)[4][2], const bf16x8 (&q)[2], float cinit) {
#pragma unroll
    for (int f = 0; f < 4; ++f) {
        s[f] = (f32x4){cinit, cinit, cinit, cinit};
#pragma unroll
        for (int dc = 0; dc < 2; ++dc) s[f] = __builtin_amdgcn_mfma_f32_16x16x32_bf16(kf[f][dc], q[dc], s[f], 0, 0, 0);
    }
}
__device__ __forceinline__ void pv(f32x4 (&o)[4], const float (&p)[4][4], const unsigned char* Vs, int r, int fq) {
    bf16x8 pb[2];
#pragma unroll
    for (int kc = 0; kc < 2; ++kc) {
        u32x4 w; w.x = cvt_pk_bf16(p[2 * kc][0], p[2 * kc][1]); w.y = cvt_pk_bf16(p[2 * kc][2], p[2 * kc][3]); w.z = cvt_pk_bf16(p[2 * kc + 1][0], p[2 * kc + 1][1]); w.w = cvt_pk_bf16(p[2 * kc + 1][2], p[2 * kc + 1][3]);
        pb[kc] = __builtin_bit_cast(bf16x8, w);
    }
#pragma unroll
    for (int df = 0; df < 4; ++df)
#pragma unroll
        for (int kc = 0; kc < 2; ++kc) {
            const int R = prow(df, r);
            const bf16x8 vf = *(const bf16x8*)(Vs + R * 128 + (((4 * kc + fq) ^ swz(R)) << 4));
            o[df] = __builtin_amdgcn_mfma_f32_16x16x32_bf16(vf, pb[kc], o[df], 0, 0, 0);
        }
}
__device__ __forceinline__ void logits(float (&v)[4][4], const f32x4 (&s)[4], int tq, int kpos0, int kstride, int fq, int H, const float* btab, float farb, bool use_tab, int wl) {
#pragma unroll
    for (int f = 0; f < 4; ++f)
#pragma unroll
        for (int i = 0; i < 4; ++i) {
            const int kk = 32 * (f >> 1) + 8 * fq + 4 * (f & 1) + i;
            const int dist = tq - (kpos0 + kstride * kk);
            const bool ok = dist >= 0 && dist < wl;
            const int di = dist < 0 ? 0 : (dist > 128 ? 128 : dist);
            v[f][i] = ok ? s[f][i] + btab[di * 16 + H] : -1e30f;
        }
}
__device__ __forceinline__ float red_max4(float x) {
    auto a = __builtin_amdgcn_permlane16_swap(__float_as_uint(x), __float_as_uint(x), false, false); x = fmaxf(__uint_as_float(a[0]), __uint_as_float(a[1]));
    auto b = __builtin_amdgcn_permlane32_swap(__float_as_uint(x), __float_as_uint(x), false, false); return fmaxf(__uint_as_float(b[0]), __uint_as_float(b[1]));
}
__device__ __forceinline__ float quad_sum(float x) {
    auto a = __builtin_amdgcn_permlane16_swap(__float_as_uint(x), __float_as_uint(x), false, false); x = __uint_as_float(a[0]) + __uint_as_float(a[1]);
    auto b = __builtin_amdgcn_permlane32_swap(__float_as_uint(x), __float_as_uint(x), false, false); return __uint_as_float(b[0]) + __uint_as_float(b[1]);
}
__device__ __forceinline__ float dpp_xor1(float x) { return __builtin_bit_cast(float, __builtin_amdgcn_update_dpp(0, __builtin_bit_cast(int, x), 0xB1, 0xF, 0xF, true)); }
__device__ __forceinline__ float dpp_xor2(float x) { return __builtin_bit_cast(float, __builtin_amdgcn_update_dpp(0, __builtin_bit_cast(int, x), 0x4E, 0xF, 0xF, true)); }
__device__ __forceinline__ float max16(const float (&v)[4][4]) {
    float a = fmaxf(fmaxf(v[0][0], v[0][1]), fmaxf(v[0][2], v[0][3])), b = fmaxf(fmaxf(v[1][0], v[1][1]), fmaxf(v[1][2], v[1][3]));
    float c = fmaxf(fmaxf(v[2][0], v[2][1]), fmaxf(v[2][2], v[2][3])), d = fmaxf(fmaxf(v[3][0], v[3][1]), fmaxf(v[3][2], v[3][3]));
    return fmaxf(fmaxf(a, b), fmaxf(c, d));
}
__device__ __forceinline__ float max3f(float a, float b, float c) { float r; asm("v_max3_f32 %0, %1, %2, %3" : "=v"(r) : "v"(a), "v"(b), "v"(c)); return r; }
__device__ __forceinline__ float max16v(const f32x4 (&s)[4]) {
    float a = max3f(s[0][0], s[0][1], s[0][2]), b = max3f(s[0][3], s[1][0], s[1][1]), c = max3f(s[1][2], s[1][3], s[2][0]), d = max3f(s[2][1], s[2][2], s[2][3]);
    a = max3f(a, s[3][0], s[3][1]); b = max3f(b, s[3][2], s[3][3]); return max3f(max3f(a, b, c), d, d);
}
template <int CGM>
__device__ __forceinline__ void pv2(f32x4 (&o)[2][4], const float (&p)[2][4][4], const unsigned char* Vs, int r, int fq) {
    bf16x8 pb[2][2];
#pragma unroll
    for (int cg_ = 0; cg_ < 2; ++cg_) if ((CGM >> cg_) & 1)
#pragma unroll
        for (int kc = 0; kc < 2; ++kc) {
            u32x4 w; w.x = cvt_pk_bf16(p[cg_][2 * kc][0], p[cg_][2 * kc][1]); w.y = cvt_pk_bf16(p[cg_][2 * kc][2], p[cg_][2 * kc][3]);
            w.z = cvt_pk_bf16(p[cg_][2 * kc + 1][0], p[cg_][2 * kc + 1][1]); w.w = cvt_pk_bf16(p[cg_][2 * kc + 1][2], p[cg_][2 * kc + 1][3]);
            pb[cg_][kc] = __builtin_bit_cast(bf16x8, w);
        }
#pragma unroll
    for (int df = 0; df < 4; ++df)
#pragma unroll
        for (int kc = 0; kc < 2; ++kc) {
            const int R = prow(df, r);
            const bf16x8 vf = *(const bf16x8*)(Vs + R * 128 + (((4 * kc + fq) ^ swz(R)) << 4));
            if (CGM & 1) o[0][df] = __builtin_amdgcn_mfma_f32_16x16x32_bf16(vf, pb[0][kc], o[0][df], 0, 0, 0);
            if (CGM & 2) o[1][df] = __builtin_amdgcn_mfma_f32_16x16x32_bf16(vf, pb[1][kc], o[1][df], 0, 0, 0);
        }
}
template <int CGM>
__device__ __forceinline__ void step_edge(const bf16x8 (&kf)[4][2], const bf16x8 (&q)[2][2], const int (&tq)[2], int key0, int fq, int H, const float* btab, int wl, const bool (&selq)[2],
                                          float (&m)[2], float (&l)[2], f32x4 (&o)[2][4], const unsigned char* Vs, int r) {
    float v[2][4][4]; float mnew[2] = {m[0], m[1]};
#pragma unroll
    for (int cg_ = 0; cg_ < 2; ++cg_) if ((CGM >> cg_) & 1) {
        f32x4 s[4]; qk(s, kf, q[cg_], 0.f); logits(v[cg_], s, tq[cg_], key0, 1, fq, H, btab, 0.f, true, wl);
        float mx = red_max4(max16(v[cg_])); if (!selq[cg_]) mx = -1e30f; mnew[cg_] = fmaxf(m[cg_], mx);
    }
    if (__any(mnew[0] > m[0] || mnew[1] > m[1])) {
#pragma unroll
        for (int cg_ = 0; cg_ < 2; ++cg_) if ((CGM >> cg_) & 1) {
            const float sc = __builtin_amdgcn_exp2f(m[cg_] - mnew[cg_]); l[cg_] *= sc; m[cg_] = mnew[cg_];
#pragma unroll
            for (int df = 0; df < 4; ++df) o[cg_][df] *= sc;
        }
    }
#pragma unroll
    for (int cg_ = 0; cg_ < 2; ++cg_) if ((CGM >> cg_) & 1) {
        const float moff = selq[cg_] ? m[cg_] : 1e30f; float rs = 0.f;
#pragma unroll
        for (int f = 0; f < 4; ++f)
#pragma unroll
            for (int i = 0; i < 4; ++i) { const float pe = __builtin_amdgcn_exp2f(v[cg_][f][i] - moff); v[cg_][f][i] = pe; rs += pe; }
        l[cg_] += rs;
    }
    pv2<CGM>(o, v, Vs, r, fq);
}
template <int CGM>
__device__ __forceinline__ void step_int(const bf16x8 (&kf)[4][2], const bf16x8 (&q)[2][2], float farb, const bool (&selq)[2],
                                         float (&m)[2], float (&l)[2], f32x4 (&o)[2][4], const unsigned char* Vs, int r, int fq) {
    f32x4 s[2][4]; float mx[2] = {-1e30f, -1e30f};
#pragma unroll
    for (int cg_ = 0; cg_ < 2; ++cg_) if ((CGM >> cg_) & 1) { qk(s[cg_], kf, q[cg_], selq[cg_] ? farb - m[cg_] : -1e30f); mx[cg_] = red_max4(max16v(s[cg_])); }
    if (__any(mx[0] > 0.f || mx[1] > 0.f)) {
#pragma unroll
        for (int cg_ = 0; cg_ < 2; ++cg_) if ((CGM >> cg_) & 1) {
            const float d = fmaxf(mx[cg_], 0.f), sc = __builtin_amdgcn_exp2f(-d); m[cg_] += d; l[cg_] *= sc;
#pragma unroll
            for (int df = 0; df < 4; ++df) o[cg_][df] *= sc;
#pragma unroll
            for (int f = 0; f < 4; ++f) s[cg_][f] -= d;
        }
    }
    float p[2][4][4];
#pragma unroll
    for (int cg_ = 0; cg_ < 2; ++cg_) if ((CGM >> cg_) & 1) {
        float rs = 0.f;
#pragma unroll
        for (int f = 0; f < 4; ++f)
#pragma unroll
            for (int i = 0; i < 4; ++i) { const float pe = __builtin_amdgcn_exp2f(s[cg_][f][i]); p[cg_][f][i] = pe; rs += pe; }
        l[cg_] += rs;
    }
    pv2<CGM>(o, p, Vs, r, fq);
}

template <bool SEL>
__device__ __forceinline__ void band_loop(unsigned char* lds, PG8_LAS unsigned char* lds3, const unsigned char* KV, int jhi, int jlo, int T, int wl,
                                          const bf16x8 (&q)[2][2], const int (&tq)[2], const unsigned long long (&sw)[2][2], int H, float farb,
                                          float (&m)[2], float (&l)[2], f32x4 (&o)[2][4], int wu, unsigned soff, int r, int fq) {
    const float* btab = (const float*)(lds + OFF_BT);
    const int n = jhi - jlo + 1;
    __syncthreads();
#pragma unroll
    for (int pi = 0; pi < 2; ++pi) if (pi < n) { const unsigned char* blk = KV + (size_t)(jhi - pi) * SLOTB; dma_block(lds3, pi, wu, blk, soff, blk + 8192, soff); }
    for (int it0 = 0; it0 < n; it0 += 2) {
        ring_wait_bar(0);
#pragma unroll
        for (int pi = 2; pi < 4; ++pi) if (it0 + pi < n) { const unsigned char* blk = KV + (size_t)(jhi - it0 - pi) * SLOTB; dma_block(lds3, (it0 + pi) & 3, wu, blk, soff, blk + 8192, soff); }
#pragma unroll 1
        for (int it = it0; it < it0 + 2 && it < n; ++it) {
            const int j = jhi - it, slot = it & 3;
            bool selq[2] = {true, true}; bool any[2] = {true, true};
            if (SEL) {
#pragma unroll
                for (int cg_ = 0; cg_ < 2; ++cg_) {
                    const unsigned long long wsel = j < 64 ? sw[cg_][0] : sw[cg_][1];
                    selq[cg_] = ((wsel >> (j & 63)) & 1ull) != 0ull; any[cg_] = __any(selq[cg_]) != 0;
                }
            }
            if (any[0] || any[1]) {
                const unsigned char* Ks = lds + OFF_RING + slot * SLOTB; const unsigned char* Vs = Ks + 8192;
                bf16x8 kf[4][2]; load_kfrags(kf, Ks, r, fq);
                const bool edge = (j >= T - 2) || (wl == 512 && j == T - 8);
                if (edge) {
                    if (any[0] && any[1]) step_edge<3>(kf, q, tq, j * 64, fq, H, btab, wl, selq, m, l, o, Vs, r);
                    else if (any[0]) step_edge<1>(kf, q, tq, j * 64, fq, H, btab, wl, selq, m, l, o, Vs, r);
                    else step_edge<2>(kf, q, tq, j * 64, fq, H, btab, wl, selq, m, l, o, Vs, r);
                } else {
                    if (any[0] && any[1]) step_int<3>(kf, q, farb, selq, m, l, o, Vs, r, fq);
                    else if (any[0]) step_int<1>(kf, q, farb, selq, m, l, o, Vs, r, fq);
                    else step_int<2>(kf, q, farb, selq, m, l, o, Vs, r, fq);
                }
            }
        }
    }
}

__device__ __forceinline__ void unitA(unsigned char* lds, PG8_LAS unsigned char* lds3, const Args& a, int b, int g, int T) {
    int tid = threadIdx.x; asm volatile("" : "+v"(tid));
    const int w = tid >> 6, wu = __builtin_amdgcn_readfirstlane(w), lane = tid & 63, c = lane & 15, fq = lane >> 4, hl = c & 3, r = c;
    const int H = 4 * g + hl, t0 = T * 64, bg = b * 2 + g;
    float* btab = (float*)(lds + OFF_BT); float* imp = (float*)(lds + OFF_IMP); unsigned* selm = (unsigned*)(lds + OFF_SEL);
    int tq[2]; bf16x8 q[2][2];
    f32x4* stash = (f32x4*)(lds + OFF_STASH);
#pragma unroll
    for (int cg_ = 0; cg_ < 2; ++cg_) {
        tq[cg_] = t0 + 8 * w + 4 * cg_ + (c >> 2);
        const bf16_t* rowp = a.PQ + (size_t)(b * SEQ + tq[cg_]) * PQ_LD;
#pragma unroll
        for (int dc = 0; dc < 2; ++dc) q[cg_][dc] = *(const bf16x8*)(rowp + H * 64 + 32 * dc + 8 * fq);
    }
#pragma unroll
    for (int cg_ = 0; cg_ < 2; ++cg_)
#pragma unroll
        for (int dc = 0; dc < 2; ++dc) asm volatile("" : "+v"(q[cg_][dc]));
    float gatev[3][2];
#pragma unroll
    for (int cg_ = 0; cg_ < 2; ++cg_)
#pragma unroll
        for (int br = 0; br < 3; ++br) { gatev[br][cg_] = bf2f(a.PQ[(size_t)(b * SEQ + tq[cg_]) * PQ_LD + 1280 + br * 8 + H]); asm volatile("" : "+v"(gatev[br][cg_])); }
#define GATE(br, cg_) fsigmoid(gatev[br][cg_])
    const float farb = btab[128 * 16 + H];
    const unsigned soff = src_off(w, lane, 128);
    __syncthreads();
    for (int i = tid; i < 64 * IMP_LD; i += 512) imp[i] = 0.f;
    f32x4 oc[2][4];
    for (int rep_ = 0; rep_ < REP_CMP; ++rep_) {
        const int NB = ((4 * T + 2) >> 6) + 1;
        const int ib_far = (64 * T - 1167) >= 0 ? (64 * T - 1167) / 1024 : -1;
        const unsigned char* Kb = (const unsigned char*)(a.KC + (size_t)bg * 512 * 64); const unsigned char* Vb = (const unsigned char*)(a.VCT + (size_t)bg * 64 * 512);
        const unsigned voffc = src_off(w, lane, 1024);
        float m[2] = {-1e30f, -1e30f}, l[2] = {0.f, 0.f}, moff[2];
        __syncthreads();
#pragma unroll
        for (int pi = 0; pi < 3; ++pi) if (pi < NB) dma_block(lds3, pi, wu, Kb + (size_t)pi * 8192, soff, Vb + pi * 128, voffc);
        for (int ib = 0; ib < NB; ++ib) {
            ring_wait_bar(NB - 1 - ib);
            if (ib + 3 < NB) dma_block(lds3, (ib + 3) & 3, wu, Kb + (size_t)(ib + 3) * 8192, soff, Vb + (ib + 3) * 128, voffc);
            const unsigned char* Ks = lds + OFF_RING + (ib & 3) * SLOTB;
            bf16x8 kf[4][2]; load_kfrags(kf, Ks, r, fq);
            const bool edge = ib > ib_far;
#pragma unroll
            for (int cg_ = 0; cg_ < 2; ++cg_) {
                f32x4 s[4]; float v[4][4];
                if (edge) { qk(s, kf, q[cg_], 0.f); logits(v, s, tq[cg_], 16 * 64 * ib + 31, 16, fq, H, btab, farb, true, 1 << 30); }
                else { qk(s, kf, q[cg_], farb);
#pragma unroll
                    for (int f = 0; f < 4; ++f)
#pragma unroll
                        for (int i = 0; i < 4; ++i) v[f][i] = s[f][i]; }
                const float mx = red_max4(max16(v)), mnew = fmaxf(m[cg_], mx), sc = __builtin_amdgcn_exp2f(m[cg_] - mnew); m[cg_] = mnew;
                float rs = 0.f;
#pragma unroll
                for (int f = 0; f < 4; ++f)
#pragma unroll
                    for (int i = 0; i < 4; ++i) rs += v[f][i] > -1e29f ? __builtin_amdgcn_exp2f(v[f][i] - mnew) : 0.f;
                l[cg_] = l[cg_] * sc + rs;
            }
        }
#pragma unroll
        for (int cg_ = 0; cg_ < 2; ++cg_) { const float lt = quad_sum(l[cg_]); moff[cg_] = lt > 0.f ? m[cg_] + __builtin_amdgcn_logf(lt) : 1e30f; }
#pragma unroll
        for (int cg_ = 0; cg_ < 2; ++cg_)
#pragma unroll
            for (int df = 0; df < 4; ++df) oc[cg_][df] = (f32x4){0.f, 0.f, 0.f, 0.f};
        __syncthreads();
#pragma unroll
        for (int pi = 0; pi < 3; ++pi) if (pi < NB) dma_block(lds3, pi, wu, Kb + (size_t)pi * 8192, soff, Vb + pi * 128, voffc);
        for (int ib = 0; ib < NB; ++ib) {
            ring_wait_bar(NB - 1 - ib);
            if (ib + 3 < NB) dma_block(lds3, (ib + 3) & 3, wu, Kb + (size_t)(ib + 3) * 8192, soff, Vb + (ib + 3) * 128, voffc);
            const unsigned char* Ks = lds + OFF_RING + (ib & 3) * SLOTB; const unsigned char* Vs = Ks + 8192;
            bf16x8 kf[4][2]; load_kfrags(kf, Ks, r, fq);
            const bool edge = ib > ib_far;
#pragma unroll
            for (int cg_ = 0; cg_ < 2; ++cg_) {
                f32x4 s[4]; float v[4][4];
                if (edge) { qk(s, kf, q[cg_], 0.f); logits(v, s, tq[cg_], 16 * 64 * ib + 31, 16, fq, H, btab, farb, true, 1 << 30);
#pragma unroll
                    for (int f = 0; f < 4; ++f)
#pragma unroll
                        for (int i = 0; i < 4; ++i) v[f][i] -= moff[cg_]; }
                else { qk(s, kf, q[cg_], farb - moff[cg_]);
#pragma unroll
                    for (int f = 0; f < 4; ++f)
#pragma unroll
                        for (int i = 0; i < 4; ++i) v[f][i] = s[f][i]; }
                const int qi = 8 * w + 4 * cg_ + (c >> 2);
#pragma unroll
                for (int f = 0; f < 4; ++f) {
#pragma unroll
                    for (int i = 0; i < 4; ++i) v[f][i] = __builtin_amdgcn_exp2f(v[f][i]);
                    float pa = v[f][0] + v[f][1] + v[f][2] + 0.5f * v[f][3], pb = 0.5f * v[f][3];
                    pa += dpp_xor1(pa); pa += dpp_xor2(pa); pb += dpp_xor1(pb); pb += dpp_xor2(pb);
                    if (hl == 0) { const int jj = 16 * ib + 8 * (f >> 1) + 2 * fq + (f & 1); atomicAdd(&imp[qi * IMP_LD + jj], pa); atomicAdd(&imp[qi * IMP_LD + jj + 1], pb); }
                }
                pv(oc[cg_], v, Vs, r, fq);
            }
        }
    }
    __syncthreads();
    for (int rep_ = 0; rep_ < REP_TOPK; ++rep_) {
        const int qi = 8 * w + (lane >> 3), gq = lane & 7;
        unsigned m16 = 0u;
        if (T <= 15) {
#pragma unroll
            for (int i = 0; i < 16; ++i) m16 |= (16 * gq + i <= T) ? (1u << i) : 0u;
        } else {
            unsigned u[16];
#pragma unroll
            for (int i = 0; i < 16; ++i) { const int j = 16 * gq + i; u[i] = (j >= 1 && j <= T - 2) ? __float_as_uint(imp[qi * IMP_LD + j]) : 0u; }
            unsigned thr = 0u;
            for (int bit = 30; bit >= 0; --bit) {
                const unsigned cand = thr | (1u << bit);
                int cnt = 0;
#pragma unroll
                for (int i = 0; i < 16; ++i) cnt += (u[i] >= cand) ? 1 : 0;
                cnt += __builtin_amdgcn_update_dpp(0, cnt, 0xB1, 0xF, 0xF, true); cnt += __builtin_amdgcn_update_dpp(0, cnt, 0x4E, 0xF, 0xF, true); cnt += __builtin_amdgcn_update_dpp(0, cnt, 0x141, 0xF, 0xF, true);
                if (cnt >= 13) thr = cand;
            }
            int ngt = 0, neq = 0;
#pragma unroll
            for (int i = 0; i < 16; ++i) { const int j = 16 * gq + i; ngt += (u[i] > thr) ? 1 : 0; neq += (u[i] == thr && j >= 1 && j <= T - 2) ? 1 : 0; }
            ngt += __builtin_amdgcn_update_dpp(0, ngt, 0xB1, 0xF, 0xF, true); ngt += __builtin_amdgcn_update_dpp(0, ngt, 0x4E, 0xF, 0xF, true); ngt += __builtin_amdgcn_update_dpp(0, ngt, 0x141, 0xF, 0xF, true);
            int before = 0;
#pragma unroll
            for (int g2 = 0; g2 < 7; ++g2) { const int other = __shfl(neq, (lane & ~7) | g2); before += (g2 < gq) ? other : 0; }
            int need = 13 - ngt - before;
#pragma unroll
            for (int i = 0; i < 16; ++i) {
                const int j = 16 * gq + i; bool sel = u[i] > thr;
                if (u[i] == thr && j >= 1 && j <= T - 2) { sel = need > 0; --need; }
                if (j == 0 || j == T - 1 || j == T) sel = true;
                m16 |= sel ? (1u << i) : 0u;
            }
        }
        const unsigned hi = (unsigned)__builtin_amdgcn_update_dpp(0, (int)m16, 0xB1, 0xF, 0xF, true);
        if ((gq & 1) == 0) selm[qi * 4 + (gq >> 1)] = m16 | (hi << 16);
    }
    __syncthreads();
#pragma unroll
    for (int cg_ = 0; cg_ < 2; ++cg_) { const float gsc = GATE(0, cg_);
#pragma unroll
        for (int df = 0; df < 4; ++df) stash[(cg_ * 4 + df) * 512 + tid] = oc[cg_][df] * gsc; }
    unsigned long long sw[2][2];
#pragma unroll
    for (int cg_ = 0; cg_ < 2; ++cg_) { const unsigned* sp = selm + (8 * w + 4 * cg_ + (c >> 2)) * 4;
        sw[cg_][0] = (unsigned long long)sp[0] | ((unsigned long long)sp[1] << 32); sw[cg_][1] = (unsigned long long)sp[2] | ((unsigned long long)sp[3] << 32); }
    for (int rep_ = 0; rep_ < REP_SEL; ++rep_) {
        float m[2] = {-1e30f, -1e30f}, l[2] = {0.f, 0.f}; f32x4 o[2][4];
#pragma unroll
        for (int cg_ = 0; cg_ < 2; ++cg_)
#pragma unroll
            for (int df = 0; df < 4; ++df) o[cg_][df] = (f32x4){0.f, 0.f, 0.f, 0.f};
        band_loop<true>(lds, lds3, (const unsigned char*)a.KVS + (size_t)bg * 128 * SLOTB, T, 0, T, 1 << 30, q, tq, sw, H, farb, m, l, o, wu, soff, r, fq);
        if (rep_ == REP_SEL - 1)
#pragma unroll
        for (int cg_ = 0; cg_ < 2; ++cg_) { const float sc = GATE(1, cg_) / quad_sum(l[cg_]);
#pragma unroll
            for (int df = 0; df < 4; ++df) stash[(cg_ * 4 + df) * 512 + tid] += o[cg_][df] * sc; }
    }
    for (int rep_ = 0; rep_ < REP_WIN; ++rep_) {
        float m[2] = {-1e30f, -1e30f}, l[2] = {0.f, 0.f}; f32x4 o[2][4];
#pragma unroll
        for (int cg_ = 0; cg_ < 2; ++cg_)
#pragma unroll
            for (int df = 0; df < 4; ++df) o[cg_][df] = (f32x4){0.f, 0.f, 0.f, 0.f};
        band_loop<false>(lds, lds3, (const unsigned char*)a.KVW + (size_t)bg * 128 * SLOTB, T, T - 8 > 0 ? T - 8 : 0, T, 512, q, tq, sw, H, farb, m, l, o, wu, soff, r, fq);
        if (rep_ == REP_WIN - 1)
#pragma unroll
        for (int cg_ = 0; cg_ < 2; ++cg_) { const float sc = GATE(2, cg_) / quad_sum(l[cg_]);
            bf16_t* op = a.OA + (size_t)(b * SEQ + tq[cg_]) * 1024 + H * 64 + 8 * fq;
#pragma unroll
            for (int e = 0; e < 2; ++e) {
                const f32x4 x0 = stash[(cg_ * 4 + 2 * e) * 512 + tid] + o[cg_][2 * e] * sc, x1 = stash[(cg_ * 4 + 2 * e + 1) * 512 + tid] + o[cg_][2 * e + 1] * sc;
                u32x4 wv; wv.x = cvt_pk_bf16(x0[0], x0[1]); wv.y = cvt_pk_bf16(x0[2], x0[3]); wv.z = cvt_pk_bf16(x1[0], x1[1]); wv.w = cvt_pk_bf16(x1[2], x1[3]);
                *(u32x4*)(op + 32 * e) = wv;
            }
        }
    }
#undef GATE
}
__device__ __forceinline__ void unitB(unsigned char* lds, PG8_LAS unsigned char* lds3, const Args& a, int b, int kvh, int T) {
    int tid = threadIdx.x; asm volatile("" : "+v"(tid));
    const int w = tid >> 6, wu = __builtin_amdgcn_readfirstlane(w), lane = tid & 63, c = lane & 15, fq = lane >> 4, hl = c & 3, r = c;
    const int hb = 4 * kvh + hl, H = 8 + hb, t0 = T * 64, bg = b * 2 + kvh;
    const float* btab = (const float*)(lds + OFF_BT);
    int tq[2]; bf16x8 q[2][2]; unsigned long long sw[2][2];
#pragma unroll
    for (int cg_ = 0; cg_ < 2; ++cg_) {
        tq[cg_] = t0 + 8 * w + 4 * cg_ + (c >> 2);
        const bf16_t* rowp = a.PQ + (size_t)(b * SEQ + tq[cg_]) * PQ_LD;
#pragma unroll
        for (int dc = 0; dc < 2; ++dc) q[cg_][dc] = *(const bf16x8*)(rowp + 1304 + hb * 64 + 32 * dc + 8 * fq);
        sw[cg_][0] = 0ull; sw[cg_][1] = 0ull;
    }
#pragma unroll
    for (int cg_ = 0; cg_ < 2; ++cg_)
#pragma unroll
        for (int dc = 0; dc < 2; ++dc) asm volatile("" : "+v"(q[cg_][dc]));
    const float farb = btab[128 * 16 + H];
    const unsigned soff = src_off(w, lane, 128);
    float m[2] = {-1e30f, -1e30f}, l[2] = {0.f, 0.f}; f32x4 o[2][4];
#pragma unroll
    for (int cg_ = 0; cg_ < 2; ++cg_)
#pragma unroll
        for (int df = 0; df < 4; ++df) o[cg_][df] = (f32x4){0.f, 0.f, 0.f, 0.f};
    band_loop<false>(lds, lds3, (const unsigned char*)a.KVB + (size_t)bg * 128 * SLOTB, T, T - 2 > 0 ? T - 2 : 0, T, 128, q, tq, sw, H, farb, m, l, o, wu, soff, r, fq);
    const float sink2 = a.sinks[hb] * LOG2E;
#pragma unroll
    for (int cg_ = 0; cg_ < 2; ++cg_) {
        const float lt = quad_sum(l[cg_]) + __builtin_amdgcn_exp2f(sink2 - m[cg_]); const float sc = 1.0f / lt;
        bf16_t* op = a.OB + (size_t)(b * SEQ + tq[cg_]) * 1024 + hb * 64 + 8 * fq;
#pragma unroll
        for (int e = 0; e < 2; ++e) {
            u32x4 wv; wv.x = cvt_pk_bf16(o[cg_][2 * e][0] * sc, o[cg_][2 * e][1] * sc); wv.y = cvt_pk_bf16(o[cg_][2 * e][2] * sc, o[cg_][2 * e][3] * sc);
            wv.z = cvt_pk_bf16(o[cg_][2 * e + 1][0] * sc, o[cg_][2 * e + 1][1] * sc); wv.w = cvt_pk_bf16(o[cg_][2 * e + 1][2] * sc, o[cg_][2 * e + 1][3] * sc);
            *(u32x4*)(op + 32 * e) = wv;
        }
    }
}
}

#define LAS __attribute__((address_space(3)))
#define XB_TMO      128
#define XB_XCNT(j)  (256  + 64 * (j))
#define XB_XSUB(j)  (1280 + 64 * (j))
#define XB_XGEN(j)  (2304 + 64 * (j))
#define XB_TOP      3328
#define XB_TOPGEN   3392
#define XCD_BAR_WORDS 3456
#define XB_SPIN_CAP (1u << 24)

__device__ __forceinline__ unsigned xb_ld(unsigned* p)              { return __hip_atomic_load(p, __ATOMIC_RELAXED, __HIP_MEMORY_SCOPE_AGENT); }
__device__ __forceinline__ unsigned xb_add(unsigned* p, unsigned v) { return __hip_atomic_fetch_add(p, v, __ATOMIC_RELAXED, __HIP_MEMORY_SCOPE_AGENT); }
__device__ __forceinline__ unsigned xb_xcc_id() { return (unsigned)__builtin_amdgcn_s_getreg((3 << 11) | 20) & 0xFu; }
#define XB_SPIN(cond, bar) do { unsigned _sp = 0; while (cond) { __builtin_amdgcn_s_sleep(1); \
    if ((++_sp & 255u) == 0u) { if (xb_ld(&(bar)[XB_TMO])) break; if (_sp > XB_SPIN_CAP) { atomicAdd(&(bar)[XB_TMO], 1u); break; } } } } while (0)

struct XcdBarrier {
    unsigned* bar; unsigned x;
    volatile LAS unsigned* st;
};

__device__ __forceinline__ XcdBarrier xcd_barrier_post(unsigned* bar, volatile LAS unsigned* st) {
    XcdBarrier b; b.bar = bar; b.x = xb_xcc_id(); b.st = st;
    if (threadIdx.x == 0) (void)xb_add(&bar[XB_XCNT(b.x)], 1u);
    return b;
}
__device__ __forceinline__ void xcd_barrier_complete(unsigned* bar, unsigned x, unsigned& nloc, unsigned& nx) {
    const unsigned G = gridDim.x * gridDim.y * gridDim.z;
    unsigned sum, cnt, mine, sp = 0u;
    for (;;) {
        sum = 0u; cnt = 0u; mine = 0u;
#pragma unroll
        for (unsigned j = 0; j < 16; ++j) { const unsigned c = xb_ld(&bar[XB_XCNT(j)]); sum += c; cnt += (c > 0u) ? 1u : 0u; mine = (j == x) ? c : mine; }
        if (sum == G) break;
        __builtin_amdgcn_s_sleep(1);
        if ((++sp & 255u) == 0u) { if (xb_ld(&bar[XB_TMO])) break; if (sp > XB_SPIN_CAP) { atomicAdd(&bar[XB_TMO], 1u); break; } }
    }
    nloc = mine > 0u ? mine : 1u; nx = cnt > 0u ? cnt : 1u;
}

__device__ __forceinline__ void xcd_barrier(const XcdBarrier& b) {
    asm volatile("s_waitcnt vmcnt(0)" ::: "memory");
    __syncthreads();
    if (threadIdx.x == 0) {
        unsigned* bar = b.bar;
        __builtin_amdgcn_s_waitcnt(0);
        __builtin_amdgcn_fence(__ATOMIC_RELEASE, "agent");
        asm volatile("s_waitcnt vmcnt(0)" ::: "memory");
        unsigned nloc = b.st[0], nx = b.st[1];
        if (nloc == 0u) { xcd_barrier_complete(bar, b.x, nloc, nx); b.st[0] = nloc; b.st[1] = nx; }
        const unsigned old = xb_add(&bar[XB_XSUB(b.x)], 1u);
        const unsigned gen = old / nloc;
        if (old + 1u == (gen + 1u) * nloc) {
            __builtin_amdgcn_fence(__ATOMIC_RELEASE, "agent");
            asm volatile("s_waitcnt vmcnt(0)" ::: "memory");
            const unsigned og = xb_add(&bar[XB_TOP], 1u);
            const unsigned tg = og / nx;
            if (og + 1u == (tg + 1u) * nx) xb_add(&bar[XB_TOPGEN], 1u);
            else XB_SPIN(xb_ld(&bar[XB_TOPGEN]) == tg, bar);
            __builtin_amdgcn_fence(__ATOMIC_ACQUIRE, "agent");
            xb_add(&bar[XB_XGEN(b.x)], 1u);
            asm volatile("s_waitcnt vmcnt(0)" ::: "memory");
        } else {
            XB_SPIN(xb_ld(&bar[XB_XGEN(b.x)]) == gen, bar);
            __builtin_amdgcn_fence(__ATOMIC_ACQUIRE, "agent");
            asm volatile("s_waitcnt vmcnt(0)" ::: "memory");
        }
    }
    __syncthreads();
}


struct CmpOrder {
    int G, c, lda, ldb;
    __device__ bool next(int i, pg8::Unit& u) const { const int L = i * G + c; if (L >= 64) return false; u.pm = L; u.pn = 0; u.aoff = (long)L * 256 * lda; u.boff = (long)(L >> 5) * 256 * ldb; return true; }
};
struct CmpOrderA {
    int G, c;
    __device__ bool next(int i, pg8::Unit& u) const {
        const int L = i * G + c; if (L >= 64) return false;
        const int kv = L >> 5, r = L & 31, bg = r >> 1, half = r & 1, b = bg >> 1, g = bg & 1;
        u.pm = L; u.pn = 0; u.aoff = (long)(b * SEQ + 16 * 256 * half) * PQ_LD + 512 + kv * 128 + g * 64; u.boff = (long)kv * 256 * 2048; return true;
    }
};
struct MemOrder {
    int c, c0, mode;
    __device__ bool next(int i, pg8::Unit& u) const {
        if (i > 0 || c < c0 || c >= c0 + 32) return false; const int L = c - c0;
        if (mode == 0) { u.pm = L >> 2; u.pn = L & 3; } else { u.pm = L >> 3; u.pn = L & 7; }
        u.aoff = (long)u.pm * 256 * 1024; u.boff = (long)u.pn * 256 * 1024; return true;
    }
};
struct XOrder {
    int G, c, mode;
    __device__ bool next(int i, pg8::Unit& u) const {
        const int L = i * G + c; if (L >= 1024) return false;
        const int h = L & 3, pm = L >> 2, b = pm >> 5;
        u.pm = pm; u.pn = h; u.aoff = (long)pm * 256 * 1024 + h * 256;
        u.boff = mode == 0 ? (long)(b * 256) * 1024 + h * 256 : (long)(h * 256) * 2048 + b * 256;
        if (mode == 2) { u.aoff = (long)pm * 256 * 1024; u.boff = (long)h * 256 * 1024; }
        return true;
    }
};

__global__ void __launch_bounds__(512, 2) fwd_megakernel(Params p) {
    extern __shared__ __attribute__((aligned(16))) unsigned char lds[];
    cg::grid_group grid = cg::this_grid();
    PG8_LAS unsigned char* lds3 = (PG8_LAS unsigned char*)lds;
    const int wave = __builtin_amdgcn_readfirstlane(threadIdx.x >> 6), G = gridDim.x, bid = blockIdx.x;
    const int gw = bid * 8 + wave, NGW = G * 8;
#define GSYNC() xcd_barrier(xbar)
#define LOCAL_TID int tid = threadIdx.x; asm volatile("" : "+v"(tid)); const int lane = tid & 63; (void)lane;
    unsigned char* ws = p.ws; unsigned char* dob = (unsigned char*)p.out;
    float* CBP = (float*)(ws + WS_CB); float* CB = CBP + 2 * 64 * 256;
    float* Lacc = (float*)(ws + WS_LP); float* SS = (float*)(ws + WS_SS);
    bf16_t* W1GU = (bf16_t*)(ws + WS_W1GU); bf16_t* W1D = (bf16_t*)(ws + WS_W1D); bf16_t* W2GU = (bf16_t*)(ws + WS_W2GU); bf16_t* W2D = (bf16_t*)(ws + WS_W2D);
    bf16_t* WIN = (bf16_t*)(ws + WS_WIN); bf16_t* WC1 = (bf16_t*)(ws + WS_WC1); bf16_t* WC2 = (bf16_t*)(ws + WS_WC2);
    bf16_t* WUA = (bf16_t*)(ws + WS_WUA); bf16_t* WUB = (bf16_t*)(ws + WS_WUB); bf16_t* WOUT = (bf16_t*)(ws + WS_WOUT);
    bf16_t* WXQ = (bf16_t*)(ws + WS_WXQ); bf16_t* WXKV = (bf16_t*)(ws + WS_WXKV); bf16_t* WXO = (bf16_t*)(ws + WS_WXO);
    bf16_t* XN = (bf16_t*)(ws + WS_XN); bf16_t* OA = (bf16_t*)(ws + WS_OA); bf16_t* OB = OA + 512;
    bf16_t* Hb = (bf16_t*)(ws + WS_H); bf16_t* PQ = (bf16_t*)(ws + WS_PQ); bf16_t* PG = (bf16_t*)(ws + WS_PG); bf16_t* MERGED = (bf16_t*)(ws + WS_MERGED);
    bf16_t* QX = (bf16_t*)(ws + WS_QX); bf16_t* PX = (bf16_t*)(ws + WS_PX); bf16_t* OX = (bf16_t*)(ws + WS_OX);
    bf16_t* MEMN = (bf16_t*)(ws + WS_MEMN); bf16_t* KM = (bf16_t*)(ws + WS_KM); bf16_t* VMT = (bf16_t*)(ws + WS_VMT);
    bf16_t* ACMP = (bf16_t*)(dob + DO_ACMP); bf16_t* HC = (bf16_t*)(dob + DO_HC); bf16_t* KC = (bf16_t*)(dob + DO_KC); bf16_t* VCT = (bf16_t*)(dob + DO_VCT);
    bf16_t* KVS = (bf16_t*)(dob + DO_KVS); bf16_t* KVW = (bf16_t*)(dob + DO_KVW); bf16_t* KVB = (bf16_t*)(dob + DO_KVB); float* Tb = (float*)(dob + DO_T);

    {
        LOCAL_TID
        float* scr = (float*)(lds + wave * 16384);
#define CONVX(idx, K_, N_, dst, ldd, kofs, kind, roff, gptr) for (int it = gw; it < ((K_) / 64) * (((N_) + 31) / 32); it += NGW) conv_item(p.in[idx], K_, N_, dst, ldd, kofs, kind, roff, gptr, scr, it, lane)
#define CONVG(idx, K_, N_, dst, kind, roff, gptr) CONVX(idx, K_, N_, dst, K_, 0, kind, roff, gptr)
#define CONV(idx, K_, N_, dst, kind, roff) CONVG(idx, K_, N_, dst, kind, roff, nullptr)
        CONV(3, 1024, 2816, W1GU, 1, 0); CONV(4, 1024, 2816, W1GU, 2, 0); CONV(5, 2816, 1024, W1D, 0, 0);
        CONVG(25, 1024, 2816, W2GU, 1, 0, p.in[24]); CONVG(26, 1024, 2816, W2GU, 2, 0, p.in[24]); CONV(27, 2816, 1024, W2D, 0, 0);
        CONVG(7, 1024, 4120, WIN, 3, 0, p.in[6]);
        CONV(9, 2048, 256, WC1, 0, 0); CONV(12, 2048, 256, WC1, 0, 256);
        CONV(10, 256, 64, WC2, 0, 0); CONV(13, 256, 64, WC2, 0, 256);
        CONVX(16, 512, 1024, WUA, 1024, 0, 0, 0, nullptr); CONVX(17, 512, 1024, WUA, 1024, 512, 0, 0, nullptr);   CONV(18, 1024, 1024, WOUT, 0, 0);
        CONVG(21, 1024, 1024, WXQ, 4, 0, p.in[19]); CONV(22, 1024, 2048, WXKV, 0, 0); CONV(23, 1024, 1024, WXO, 0, 0);
#undef CONV
#undef CONVG
#undef CONVX
        const int gt = bid * 512 + tid, GT = G * 512;
        for (int i = gt; i < 232 * 1024 / 8; i += GT) *((u32x4*)(WIN + (size_t)2072 * 1024) + i) = (u32x4){0u, 0u, 0u, 0u};
        for (int i = gt; i < 192 * 256 / 8; i += GT) { *((u32x4*)(WC2 + 64 * 256) + i) = (u32x4){0u, 0u, 0u, 0u}; *((u32x4*)(WC2 + 320 * 256) + i) = (u32x4){0u, 0u, 0u, 0u}; }
        rms_pass(p.in[0], p.in[2], XN, nullptr, M, gw, NGW);
        rms_pass(p.in[1], p.in[20], MEMN, nullptr, 2048, gw, NGW);
        for (int t = gw; t < 512; t += NGW) {
            const int kv = t >> 8, kc = (t >> 2) & 63, c = (t & 3) * 64 + lane; const float* pe = p.in[kv ? 11 : 8] + kc * 32; const float* w1 = p.in[kv ? 12 : 9] + (size_t)kc * 32 * 256 + c;
            float a0 = 0.f, a1 = 0.f, a2 = 0.f, a3 = 0.f;
            for (int k = 0; k < 32; k += 4) { a0 += pe[k] * w1[(size_t)k * 256]; a1 += pe[k + 1] * w1[(size_t)(k + 1) * 256]; a2 += pe[k + 2] * w1[(size_t)(k + 2) * 256]; a3 += pe[k + 3] * w1[(size_t)(k + 3) * 256]; }
            CBP[(kv * 64 + kc) * 256 + c] = (a0 + a1) + (a2 + a3);
        }
        if (bid == 0) for (int i = tid; i < (int)(BAR_BYTES / 4); i += 512) ((unsigned*)p.ws)[i] = 0u;
    }
    grid.sync();
    { volatile LAS unsigned* st = (volatile LAS unsigned*)(lds3 + BAR_LDS_OFF); if (threadIdx.x < 2) st[threadIdx.x] = 0u; __syncthreads(); }
    const XcdBarrier xbar = xcd_barrier_post((unsigned*)p.ws, (volatile LAS unsigned*)(lds3 + BAR_LDS_OFF));
    { const int gt = bid * 512 + (int)threadIdx.x; if (gt < 512) { float t0 = 0.f, t1 = 0.f, t2 = 0.f, t3 = 0.f; for (int kc = 0; kc < 64; kc += 4) { const float* q_ = CBP + ((gt >> 8) * 64 + kc) * 256 + (gt & 255); t0 += q_[0]; t1 += q_[256]; t2 += q_[512]; t3 += q_[768]; } CB[gt] = (t0 + t1) + (t2 + t3); } }
    { pg8::Gemm g{XN, W1GU, 1024, 1024, 1024}; pg8::StaticOrder S; S.init(M, 5632, 1024, 1024, G, bid); pg8::EpiSwiglu E{Hb, DFF, nullptr}; pg8::gemm_phase(lds3, g, S, E); }
    GSYNC();
    { pg8::Gemm g{Hb, W1D, DFF, DFF, DFF}; pg8::StaticOrder S; S.init(M, 1024, DFF, DFF, G, bid); pg8::EpiResid E{p.in[0], XN, SS, 0.5f}; pg8::gemm_phase(lds3, g, S, E); }
    GSYNC();
    { pg8::Gemm g{XN, WIN, 1024, 1024, 1024}; pg8::StaticOrder S; S.init(M, 4352, 1024, 1024, G, bid); pg8::EpiBf16 E{PQ, PQ_LD, 9, PG, PG_LD, 0, 1, nullptr, SS, nullptr}; pg8::gemm_phase(lds3, g, S, E); }
    GSYNC();
    { pg8::Gemm g{PQ, WC1, 16 * PQ_LD, 2048, 2048, PQ_LD * 2}; CmpOrderA S{G, bid}; pg8::EpiBf16 E{HC, 256, 1 << 30, nullptr, 0, 2, 0, nullptr, nullptr, CB}; pg8::gemm_phase(lds3, g, S, E); }
    { pg8::Gemm g{MEMN, WXKV, 1024, 1024, 1024}; MemOrder S{bid, G >= 128 ? 64 : 0, 0}; pg8::EpiBf16 E{KM, 1024, 1 << 30, nullptr, 0, 0, 0, nullptr, nullptr, nullptr}; pg8::gemm_phase(lds3, g, S, E); }
    if (G < 128 || bid >= 64) {
        LOCAL_TID
        const int cb0 = G < 128 ? bid : bid - 64, cG = G < 128 ? G : G - 64;
        bf16_t* tile = (bf16_t*)lds;
        for (int it0 = cb0; it0 < 3 * 16 * 128; it0 += 2 * cG) {
            const int row = tid >> 3, ch = tid & 7;
            const bool two = (it0 + cG) < 3 * 16 * 128;
            u32x4 kx[2], vx[2]; bf16_t* blk[2];
#pragma unroll
            for (int z = 0; z < 2; ++z) {
                const int it = (z == 0 || two) ? it0 + z * cG : it0;
                const int tb = it & 127, bg = (it >> 7) & 15, x = it >> 11, b = bg >> 1, g = bg & 1;
                const int kcol = (x == 0 ? 768 : (x == 1 ? 1024 : 1816)) + g * 64, vcol = (x == 0 ? 896 : (x == 1 ? 1152 : 1944)) + g * 64;
                blk[z] = (x == 0 ? KVS : (x == 1 ? KVW : KVB)) + (size_t)(bg * 128 + tb) * 8192;
                const bf16_t* src = PQ + (size_t)(b * SEQ + tb * 64 + row) * PQ_LD;
                kx[z] = *(const u32x4*)(src + kcol + ch * 8); vx[z] = *(const u32x4*)(src + vcol + ch * 8);
            }
            __syncthreads();
#pragma unroll
            for (int z = 0; z < 2; ++z) { if (z == 0 || two) *(u32x4*)(blk[z] + row * 64 + ch * 8) = kx[z]; *(u32x4*)(tile + z * 64 * 72 + row * 72 + ch * 8) = vx[z]; }
            __syncthreads();
#pragma unroll
            for (int z = 0; z < 2; ++z) {
                unsigned short e[8];
#pragma unroll
                for (int k = 0; k < 8; ++k) e[k] = tile[z * 64 * 72 + (ch * 8 + k) * 72 + row];
                u32x4 o; o.x = e[0] | ((unsigned)e[1] << 16); o.y = e[2] | ((unsigned)e[3] << 16); o.z = e[4] | ((unsigned)e[5] << 16); o.w = e[6] | ((unsigned)e[7] << 16);
                if (z == 0 || two) *(u32x4*)(blk[z] + 4096 + row * 64 + ch * 8) = o;
            }
        }
        __syncthreads();
    }
    { pg8::Gemm g{WXKV + (size_t)1024 * 1024, MEMN, 1024, 1024, 1024}; MemOrder S{bid, G >= 128 ? 96 : 0, 1}; pg8::EpiBf16 E{VMT, 2048, 1 << 30, nullptr, 0, 0, 0, nullptr, nullptr, nullptr}; pg8::gemm_phase(lds3, g, S, E); }
    GSYNC();
    { pg8::Gemm g{HC, WC2, 256, 256, 256}; CmpOrder S{G, bid, 256, 256}; pg8::EpiCmp2 E{KC, VCT}; pg8::gemm_phase(lds3, g, S, E); }
    GSYNC();
    {
        LOCAL_TID
        float* btab = (float*)(lds + att::OFF_BT);
        __syncthreads();
        for (int i = tid; i < 129 * 16; i += 512) { const int d = i >> 4, hh = i & 15; const int bk = d < 128 ? t5_bucket(d) : 31; btab[i] = p.in[15][bk * 16 + hh] * LOG2E; }
        __syncthreads();
        att::Args a{PQ, KC, VCT, KVS, KVW, KVB, OA, OB, p.in[14]};
        const bool xo = (G == 256); const int nun = xo ? 8 : (2048 - bid + G - 1) / G;
        for (int i = 0; i < 2 * nun; ++i) {
            const int iu = i < nun ? i : i - nun; int bg, T;
            if (xo) { const int x = bid & 7, wi = bid >> 3, ii = iu & 3; bg = (iu < 4) ? x : x + 8; T = ii == 0 ? wi : (ii == 1 ? 63 - wi : (ii == 2 ? 64 + wi : 127 - wi)); }
            else { const int idx = bid + iu * G, tt = idx >> 4, i2 = tt >> 4, k = tt & 15; bg = idx & 15; T = (i2 & 1) ? (16 * i2 + 15 - k) : (16 * i2 + k); }
            if (i < nun) att::unitA(lds, lds3, a, bg >> 1, bg & 1, T); else att::unitB(lds, lds3, a, bg >> 1, bg & 1, T);
        }
        __syncthreads();
    }
    GSYNC();
    { pg8::Gemm g{OA, WUA, 1024, 1024, 1024}; pg8::StaticOrder S; S.init(M, 1024, 1024, 1024, G, bid); pg8::EpiGate E{PG, PG_LD, MERGED}; pg8::gemm_phase(lds3, g, S, E); }
    GSYNC();
    { pg8::Gemm g{MERGED, WOUT, 1024, 1024, 1024}; pg8::StaticOrder S; S.init(M, 1024, 1024, 1024, G, bid); pg8::EpiResid E{nullptr, XN, SS + (size_t)16 * M, 1.0f}; pg8::gemm_phase(lds3, g, S, E); }
    GSYNC();
    { pg8::Gemm g{XN, WXQ, 1024, 1024, 1024}; XOrder S{G, bid, 2}; pg8::EpiBf16 E{QX, 1024, 1 << 30, nullptr, 0, 0, 0, nullptr, SS + (size_t)16 * M, nullptr}; pg8::gemm_phase(lds3, g, S, E); }
    GSYNC();
    { pg8::Gemm g{QX, KM, 1024, 1024, 256}; XOrder S{G, bid, 0}; pg8::EpiXS E{PX, Lacc}; pg8::gemm_phase(lds3, g, S, E); }
    GSYNC();
    { pg8::Gemm g{PX, VMT, 1024, 2048, 256}; XOrder S{G, bid, 1}; pg8::EpiBf16 E{OX, 1024, 1 << 30, nullptr, 0, 0, 0, Lacc, nullptr, nullptr}; pg8::gemm_phase(lds3, g, S, E); }
    GSYNC();
    { pg8::Gemm g{OX, WXO, 1024, 1024, 1024}; pg8::StaticOrder S; S.init(M, 1024, 1024, 1024, G, bid); pg8::EpiResid E{nullptr, XN, SS + (size_t)32 * M, 1.0f}; pg8::gemm_phase(lds3, g, S, E); }
    GSYNC();
    { pg8::Gemm g{XN, W2GU, 1024, 1024, 1024}; pg8::StaticOrder S; S.init(M, 5632, 1024, 1024, G, bid); pg8::EpiSwiglu E{Hb, DFF, SS + (size_t)32 * M}; pg8::gemm_phase(lds3, g, S, E); }
    GSYNC();
    { pg8::Gemm g{Hb, W2D, DFF, DFF, DFF}; pg8::StaticOrder S; S.init(M, 1024, DFF, DFF, G, bid); pg8::EpiResid E{nullptr, XN, nullptr, 0.5f}; pg8::gemm_phase(lds3, g, S, E); }
    GSYNC();
    rms_final(XN, p.in[28], p.out, M, gw, NGW);
}

extern "C" void kernel_launch(void* const* d_in, const int* in_sizes, int n_in, void* d_out, int out_size, void* d_ws, size_t ws_size, hipStream_t stream) {
    static int grid = 0; constexpr int LDS_BYTES = 147456;
    if (grid == 0) {
        if (n_in != 29 || out_size != M * DM || ws_size < WS_END) { fprintf(stderr, "kernel_launch: unexpected shapes (n_in %d out %d ws %zu)\n", n_in, out_size, ws_size); grid = -1; return; }
        int dev = 0, cus = 0, per_cu = 0;
        (void)hipGetDevice(&dev); (void)hipDeviceGetAttribute(&cus, hipDeviceAttributeMultiprocessorCount, dev);
        (void)hipFuncSetAttribute((const void*)fwd_megakernel, hipFuncAttributeMaxDynamicSharedMemorySize, LDS_BYTES);
        (void)hipOccupancyMaxActiveBlocksPerMultiprocessor(&per_cu, (const void*)fwd_megakernel, 512, LDS_BYTES);
        if (per_cu < 1) fprintf(stderr, "kernel_launch: occupancy query says %d blocks per CU\n", per_cu);
        (void)hipGetLastError();
        grid = cus > 0 ? cus : 256;
    }
    if (grid < 0) return;
    Params p{};
    for (int i = 0; i < 29; ++i) p.in[i] = (const float*)d_in[i];
    p.out = (float*)d_out; p.ws = (unsigned char*)d_ws;
    void* args[] = {&p};
    hipError_t e = hipLaunchCooperativeKernel((const void*)fwd_megakernel, dim3(grid), dim3(512), args, LDS_BYTES, stream);
    if (e != hipSuccess) fprintf(stderr, "cooperative launch failed: %s (grid %d)\n", hipGetErrorString(e), grid);
}
```

```cpp
#include <hip/hip_runtime.h>
#include <hip/hip_cooperative_groups.h>
#include <cstdio>
#include <cstdint>
namespace cg = cooperative_groups;

namespace pg8 {
#define PG8_LAS __attribute__((address_space(3)))
typedef unsigned short bf16_t;
typedef short bf16x8 __attribute__((ext_vector_type(8)));
typedef float f32x4 __attribute__((ext_vector_type(4)));
typedef unsigned u32x4 __attribute__((ext_vector_type(4)));
typedef unsigned u32x2 __attribute__((ext_vector_type(2)));
constexpr int BM = 256, BK = 64, HALF = 128, HTB = HALF * BK * 2, STAGE_BYTES = 8 * HTB, NXCD = 8, WGM = 8;

__host__ __device__ __forceinline__ int lds_byte(int r, int c) { const int st = (r >> 4) * 2 + (c >> 5), rr = r & 15, cc = c & 31, ob = rr * 64 + cc * 2; return st * 1024 + (ob ^ (((ob >> 9) & 1) << 5)); }
__host__ __device__ __forceinline__ void stage_rc(int b, int& R, int& C) { const int st = b / 1024, sb = b % 1024, swz = sb ^ (((sb >> 9) & 1) << 5); R = (st >> 1) * 16 + swz / 64; C = (st & 1) * 32 + (swz % 64) / 2; }
__host__ __device__ __forceinline__ int perm32(int rho) { const int n = rho >> 4, i = rho & 15; return 8 * (i >> 2) + 4 * n + (i & 3); }

struct Unit { int pm, pn; long aoff, boff; };
struct Gemm { const bf16_t* A; const bf16_t* Bt; int lda, ldb, K; int ksa = 128; };

struct StaticOrder {
    int nM, nN, nwg, G, c, lda, ldb;
    __device__ void init(int M, int N, int lda_, int ldb_, int G_, int c_) { nM = M / BM; nN = N / BM; nwg = nM * nN; G = G_; c = c_; lda = lda_; ldb = ldb_; }
    __device__ bool next(int i, Unit& u) const {
        const long L = (long)i * G + c; if (L >= nwg) return false;
        int wgid = (int)L; { const int q = nwg / NXCD, r = nwg % NXCD, xcd = wgid % NXCD, off = wgid / NXCD; wgid = (xcd < r ? xcd * (q + 1) : r * (q + 1) + (xcd - r) * q) + off; }
        const int nig = WGM * nN, gid = wgid / nig, fm = gid * WGM, gsz = (nM - fm) < WGM ? (nM - fm) : WGM;
        u.pm = fm + ((wgid % nig) % gsz); u.pn = (wgid % nig) / gsz;
        u.aoff = (long)u.pm * BM * lda; u.boff = (long)u.pn * BM * ldb; return true;
    }
};

__device__ __forceinline__ unsigned cvt_pk_bf16(float lo, float hi) { unsigned r; asm volatile("v_cvt_pk_bf16_f32 %0, %1, %2" : "=v"(r) : "v"(lo), "v"(hi)); return r; }
__device__ __forceinline__ float bf2f(unsigned short v) { return __uint_as_float(((unsigned)v) << 16); }
__device__ __forceinline__ float fsigmoid(float x) { return __builtin_amdgcn_rcpf(1.0f + __builtin_amdgcn_exp2f(-1.4426950408889634f * x)); }


__device__ __forceinline__ float row_rstd(const float* ssp, int row) {
    const f32x4* p4 = (const f32x4*)(ssp + (size_t)row * 16); const f32x4 a = p4[0], b = p4[1], c = p4[2], d = p4[3];
    const float t = (((a[0] + a[1]) + (a[2] + a[3])) + ((b[0] + b[1]) + (b[2] + b[3]))) + (((c[0] + c[1]) + (c[2] + c[3])) + ((d[0] + d[1]) + (d[2] + d[3])));
    return __builtin_amdgcn_rsqf(t * (1.f / 1024.f) + 1e-6f);
}
struct EpiSwiglu {
    static constexpr bool PERM = true;
    bf16_t* H; int ldh; const float* ss;
    __device__ __forceinline__ void operator()(const f32x4 (&acc)[2][2][4][2], const Unit& u, int wr, int wc, int fr, int fq) const {
        const int row0 = u.pm * BM + wr * 64 + fr, col0 = u.pn * 128 + wc * 32 + 8 * fq;
#pragma unroll
        for (int ai = 0; ai < 2; ++ai) {
            float rsv[4];
#pragma unroll
            for (int m = 0; m < 4; ++m) rsv[m] = ss ? row_rstd(ss, row0 + ai * HALF + m * 16) : 1.0f;
#pragma unroll
            for (int m = 0; m < 4; ++m) {
                bf16_t* p = H + (size_t)(row0 + ai * HALF + m * 16) * ldh + col0;
                const float rs = rsv[m];
                float h[8];
#pragma unroll
                for (int n = 0; n < 2; ++n)
#pragma unroll
                    for (int e = 0; e < 4; ++e) { const float gv = acc[ai][0][m][n][e] * rs, uv = acc[ai][1][m][n][e] * rs; h[n * 4 + e] = gv * fsigmoid(gv) * uv; }
                u32x4 w; w.x = cvt_pk_bf16(h[0], h[1]); w.y = cvt_pk_bf16(h[2], h[3]); w.z = cvt_pk_bf16(h[4], h[5]); w.w = cvt_pk_bf16(h[6], h[7]);
                *(u32x4*)p = w;
            }
        }
    }
};
struct EpiResid {
    static constexpr bool PERM = true;
    const float* basef; bf16_t* xs; float* ss; float alpha;
    __device__ __forceinline__ void operator()(const f32x4 (&acc)[2][2][4][2], const Unit& u, int wr, int wc, int fr, int fq) const {
        const int col0 = u.pn * BM + wc * 32 + 8 * fq;
#pragma unroll
        for (int ai = 0; ai < 2; ++ai)
#pragma unroll
        for (int mh = 0; mh < 2; ++mh) {
            f32x4 bf[2][2][2]; u32x4 bh[2][2];
#pragma unroll
            for (int m2 = 0; m2 < 2; ++m2)
#pragma unroll
                for (int bj = 0; bj < 2; ++bj) {
                    const size_t off = (size_t)(u.pm * BM + ai * HALF + wr * 64 + (2 * mh + m2) * 16 + fr) * 1024 + col0 + bj * HALF;
                    if (!basef) bh[m2][bj] = *(const u32x4*)(xs + off);
                }
#pragma unroll
            for (int m2 = 0; m2 < 2; ++m2) {
                const int m = 2 * mh + m2;
                const int row = u.pm * BM + ai * HALF + wr * 64 + m * 16 + fr; float sq = 0.f;
                if (basef) {
#pragma unroll
                    for (int bj = 0; bj < 2; ++bj) { const size_t off = (size_t)row * 1024 + col0 + bj * HALF; bf[m2][bj][0] = *(const f32x4*)(basef + off); bf[m2][bj][1] = *(const f32x4*)(basef + off + 4); }
                }
#pragma unroll
                for (int bj = 0; bj < 2; ++bj) {
                    const size_t off = (size_t)row * 1024 + col0 + bj * HALF;
                    float bv[8];
                    if (basef) { const f32x4 b0 = bf[m2][bj][0], b1 = bf[m2][bj][1]; bv[0] = b0[0]; bv[1] = b0[1]; bv[2] = b0[2]; bv[3] = b0[3]; bv[4] = b1[0]; bv[5] = b1[1]; bv[6] = b1[2]; bv[7] = b1[3]; }
                    else { const u32x4 gw = bh[m2][bj];
                        bv[0] = __uint_as_float(gw.x << 16); bv[1] = __uint_as_float(gw.x & 0xffff0000u); bv[2] = __uint_as_float(gw.y << 16); bv[3] = __uint_as_float(gw.y & 0xffff0000u);
                        bv[4] = __uint_as_float(gw.z << 16); bv[5] = __uint_as_float(gw.z & 0xffff0000u); bv[6] = __uint_as_float(gw.w << 16); bv[7] = __uint_as_float(gw.w & 0xffff0000u); }
                    float y[8];
#pragma unroll
                    for (int e = 0; e < 4; ++e) { y[e] = bv[e] + alpha * acc[ai][bj][m][0][e]; y[4 + e] = bv[4 + e] + alpha * acc[ai][bj][m][1][e]; }
                    u32x4 w; w.x = cvt_pk_bf16(y[0], y[1]); w.y = cvt_pk_bf16(y[2], y[3]); w.z = cvt_pk_bf16(y[4], y[5]); w.w = cvt_pk_bf16(y[6], y[7]);
                    *(u32x4*)(xs + off) = w;
                    if (ss) sq += ((y[0] * y[0] + y[1] * y[1]) + (y[2] * y[2] + y[3] * y[3])) + ((y[4] * y[4] + y[5] * y[5]) + (y[6] * y[6] + y[7] * y[7]));
                }
                if (ss) { sq += __shfl_xor(sq, 16); sq += __shfl_xor(sq, 32); if (fq == 0) ss[(size_t)row * 16 + u.pn * 4 + wc] = sq; }
            }
        }
    }
};
struct EpiBf16 {
    static constexpr bool PERM = true;
    bf16_t* O0; int ld0; int split_pn; bf16_t* O1; int ld1; int act0, act1; const float* rowscale; const float* ss; const float* cbias;
    __device__ __forceinline__ void operator()(const f32x4 (&acc)[2][2][4][2], const Unit& u, int wr, int wc, int fr, int fq) const {
        bf16_t* O = O0; int ld = ld0, colt = u.pn * BM, act = act0;
        if (u.pn >= split_pn) { O = O1; ld = ld1; colt = (u.pn - split_pn) * BM; act = act1; }
        const int row0 = u.pm * BM + wr * 64 + fr, col0 = colt + wc * 32 + 8 * fq;
        float rsv[2][4];
#pragma unroll
        for (int ai = 0; ai < 2; ++ai)
#pragma unroll
            for (int m = 0; m < 4; ++m) {
                const int row = row0 + ai * HALF + m * 16;
                float rs = 1.0f; if (rowscale) { const f32x4 lp = *(const f32x4*)(rowscale + ((size_t)row * 4 + u.pn) * 4); rs = __builtin_amdgcn_rcpf((lp[0] + lp[1]) + (lp[2] + lp[3])); }
                if (ss) rs = row_rstd(ss, row);
                rsv[ai][m] = rs;
            }
#pragma unroll
        for (int ai = 0; ai < 2; ++ai)
#pragma unroll
            for (int m = 0; m < 4; ++m) {
                const int row = row0 + ai * HALF + m * 16;
                const float rs = rsv[ai][m];
                bf16_t* rowp = O + (size_t)row * ld + col0;
#pragma unroll
                for (int bj = 0; bj < 2; ++bj) {
                    float h[8];
#pragma unroll
                    for (int n = 0; n < 2; ++n)
#pragma unroll
                        for (int e = 0; e < 4; ++e) {
                            float x = acc[ai][bj][m][n][e] * rs;
                            if (cbias) x += cbias[(u.pm >> 5) * 256 + (col0 - colt) + bj * HALF + n * 4 + e];
                            if (act == 1) x = fsigmoid(x);
                            else if (act == 2) { const float z = 1.5957691216057308f * (x + 0.044715f * x * x * x); x = x * fsigmoid(z); }
                            h[n * 4 + e] = x;
                        }
                    u32x4 w; w.x = cvt_pk_bf16(h[0], h[1]); w.y = cvt_pk_bf16(h[2], h[3]); w.z = cvt_pk_bf16(h[4], h[5]); w.w = cvt_pk_bf16(h[6], h[7]);
                    *(u32x4*)(rowp + bj * HALF) = w;
                }
            }
    }
};
struct EpiCmp2 {
    static constexpr bool PERM = true;
    bf16_t* KC; bf16_t* VCT;
    __device__ __forceinline__ void operator()(const f32x4 (&acc)[2][2][4][2], const Unit& u, int wr, int wc, int fr, int fq) const {
        if (wc >= 2) return;
        const int col0 = wc * 32 + 8 * fq;
#pragma unroll
        for (int ai = 0; ai < 2; ++ai)
#pragma unroll
            for (int m = 0; m < 4; ++m) {
                const int row = u.pm * BM + ai * HALF + wr * 64 + m * 16 + fr;
                if (u.pm < 32) {
                    u32x4 w; w.x = cvt_pk_bf16(acc[ai][0][m][0][0], acc[ai][0][m][0][1]); w.y = cvt_pk_bf16(acc[ai][0][m][0][2], acc[ai][0][m][0][3]);
                    w.z = cvt_pk_bf16(acc[ai][0][m][1][0], acc[ai][0][m][1][1]); w.w = cvt_pk_bf16(acc[ai][0][m][1][2], acc[ai][0][m][1][3]);
                    *(u32x4*)(KC + (size_t)row * 64 + col0) = w;
                } else {
                    const int r2 = row - 8192, bg = r2 >> 9, n = r2 & 511;
#pragma unroll
                    for (int nn = 0; nn < 2; ++nn)
#pragma unroll
                        for (int e = 0; e < 4; ++e) VCT[(size_t)(bg * 64 + col0 + nn * 4 + e) * 512 + n] = (bf16_t)(cvt_pk_bf16(acc[ai][0][m][nn][e], 0.f) & 0xffffu);
                }
            }
    }
};
__device__ __forceinline__ void unpack8(float (&gv)[8], const u32x4& gw) {
    gv[0] = __uint_as_float(gw.x << 16); gv[1] = __uint_as_float(gw.x & 0xffff0000u); gv[2] = __uint_as_float(gw.y << 16); gv[3] = __uint_as_float(gw.y & 0xffff0000u);
    gv[4] = __uint_as_float(gw.z << 16); gv[5] = __uint_as_float(gw.z & 0xffff0000u); gv[6] = __uint_as_float(gw.w << 16); gv[7] = __uint_as_float(gw.w & 0xffff0000u);
}
struct EpiGate {
    static constexpr bool PERM = true, HOOK = true;
    const bf16_t* gate; int ldg; bf16_t* MO;
    __device__ __forceinline__ void hook(f32x4 (&acc)[2][2][4][2], const Unit& u, int wr, int wc, int fr, int fq) const {
        int row0 = u.pm * BM + wr * 64 + fr, col0 = u.pn * BM + wc * 32 + 8 * fq;
        asm volatile("" : "+v"(row0), "+v"(col0));
#pragma unroll
        for (int ai = 0; ai < 2; ++ai)
#pragma unroll
            for (int mh = 0; mh < 2; ++mh) {
                u32x4 ra[2][2], rb[2][2];
#pragma unroll
                for (int m2 = 0; m2 < 2; ++m2)
#pragma unroll
                    for (int bj = 0; bj < 2; ++bj) {
                        const unsigned goff = ((unsigned)(row0 + ai * HALF + (2 * mh + m2) * 16) * (unsigned)ldg + (unsigned)(col0 + bj * HALF)) * 2u;
                        ra[m2][bj] = *(const u32x4*)((const char*)gate + goff); rb[m2][bj] = *(const u32x4*)((const char*)gate + 2048 + goff);
                    }
#pragma unroll
                for (int m2 = 0; m2 < 2; ++m2)
#pragma unroll
                    for (int bj = 0; bj < 2; ++bj) {
                        const int m = 2 * mh + m2; float ga[8], gb[8]; unpack8(ga, ra[m2][bj]); unpack8(gb, rb[m2][bj]);
#pragma unroll
                        for (int e = 0; e < 4; ++e) { acc[ai][bj][m][0][e] *= ga[e] * __builtin_amdgcn_rcpf(gb[e]); acc[ai][bj][m][1][e] *= ga[4 + e] * __builtin_amdgcn_rcpf(gb[4 + e]); }
                    }
                asm volatile("" ::: "memory");
            }
    }
    __device__ __forceinline__ void operator()(const f32x4 (&acc)[2][2][4][2], const Unit& u, int wr, int wc, int fr, int fq) const {
        const int row0 = u.pm * BM + wr * 64 + fr, col0 = u.pn * BM + wc * 32 + 8 * fq;
#pragma unroll
        for (int ai = 0; ai < 2; ++ai) {
            u32x4 rb[4][2];
#pragma unroll
            for (int m = 0; m < 4; ++m)
#pragma unroll
                for (int bj = 0; bj < 2; ++bj) rb[m][bj] = *(const u32x4*)((const char*)gate + 2048 + ((unsigned)(row0 + ai * HALF + m * 16) * (unsigned)ldg + (unsigned)(col0 + bj * HALF)) * 2u);
#pragma unroll
            for (int m = 0; m < 4; ++m)
#pragma unroll
                for (int bj = 0; bj < 2; ++bj) {
                    const int row = row0 + ai * HALF + m * 16, col = col0 + bj * HALF;
                    float gb[8]; unpack8(gb, rb[m][bj]);
                    const f32x4 a0 = acc[ai][bj][m][0], a1 = acc[ai][bj][m][1];
                    u32x4 w; w.x = cvt_pk_bf16(a0[0] * gb[0], a0[1] * gb[1]); w.y = cvt_pk_bf16(a0[2] * gb[2], a0[3] * gb[3]); w.z = cvt_pk_bf16(a1[0] * gb[4], a1[1] * gb[5]); w.w = cvt_pk_bf16(a1[2] * gb[6], a1[3] * gb[7]);
                    *(u32x4*)(MO + (size_t)row * 1024 + col) = w;
                }
        }
    }
};
struct EpiXS {
    static constexpr bool PERM = true;
    bf16_t* P; float* L;
    __device__ __forceinline__ void operator()(const f32x4 (&acc)[2][2][4][2], const Unit& u, int wr, int wc, int fr, int fq) const {
        const int row0 = u.pm * BM + wr * 64 + fr, col0 = u.pn * BM + wc * 32 + 8 * fq;
#pragma unroll
        for (int ai = 0; ai < 2; ++ai)
#pragma unroll
            for (int m = 0; m < 4; ++m) {
                const int row = row0 + ai * HALF + m * 16; float rsum = 0.f;
#pragma unroll
                for (int bj = 0; bj < 2; ++bj) {
                    float h[8];
#pragma unroll
                    for (int n = 0; n < 2; ++n)
#pragma unroll
                        for (int e = 0; e < 4; ++e) { const float pe = __builtin_amdgcn_exp2f(fminf(acc[ai][bj][m][n][e], 100.f)); h[n * 4 + e] = pe; rsum += pe; }
                    u32x4 w; w.x = cvt_pk_bf16(h[0], h[1]); w.y = cvt_pk_bf16(h[2], h[3]); w.z = cvt_pk_bf16(h[4], h[5]); w.w = cvt_pk_bf16(h[6], h[7]);
                    *(u32x4*)(P + (size_t)row * 1024 + col0 + bj * HALF) = w;
                }
                rsum += __shfl_xor(rsum, 16); rsum += __shfl_xor(rsum, 32);
                if (fq == 0) L[((size_t)row * 4 + u.pn) * 4 + wc] = rsum;
            }
    }
};

template <class E, class = void> struct epi_has_hook { static constexpr bool value = false; };
template <class E> struct epi_has_hook<E, decltype((void)E::HOOK)> { static constexpr bool value = E::HOOK; };
template <class Epi, class Sched>
__device__ __forceinline__ void gemm_phase(PG8_LAS unsigned char* lds, const Gemm g, const Sched& S, const Epi& E) {
    int tid = threadIdx.x; asm volatile("" : "+v"(tid));
    const int wid = __builtin_amdgcn_readfirstlane(tid >> 6), lane = tid & 63, wr = wid >> 2, wc = wid & 3, fr = lane & 15, fq = lane >> 4;
    const int K = g.K, nt = K / BK;
    unsigned voffA[2], voffB[2];
#pragma unroll
    for (int i = 0; i < 2; ++i) { int R, C; stage_rc(tid * 16 + i * 8192, R, C); const int Rb = Epi::PERM ? ((R & ~31) + perm32(R & 31)) : R;
        voffA[i] = (unsigned)(R * g.lda + C) * 2u; voffB[i] = (unsigned)(Rb * g.ldb + C) * 2u; }
    const size_t kstep = (size_t)(BK * 2), kstepA = (size_t)g.ksa;
    const size_t hstepA = (size_t)HALF * g.lda * 2, hstepB = (size_t)HALF * g.ldb * 2;
    const unsigned ldsw = (unsigned)wid * 1024u;
    const int aoff = lds_byte(wr * 64 + fr, fq * 8), boff = lds_byte(wc * 32 + fr, fq * 8);
#define PG8_SA(b, h) (((b) * 2 + (h)) * HTB)
#define PG8_SB(b, h) ((4 + (b) * 2 + (h)) * HTB)
#define PG8_STAGE(bufoff, gbase, voff) do { _Pragma("unroll") for (int _i = 0; _i < 2; ++_i) \
        __builtin_amdgcn_global_load_lds((const unsigned*)((const char*)(gbase) + (voff)[_i]), (PG8_LAS unsigned*)(lds + (bufoff) + ldsw + _i * 8192), 16, 0, 0); } while (0)
#define PG8_LDA(dst, b, h) do { _Pragma("unroll") for (int m = 0; m < 4; ++m) _Pragma("unroll") for (int k = 0; k < 2; ++k) dst[m][k] = *(const PG8_LAS bf16x8*)(lds + PG8_SA(b, h) + aoff + m * 2048 + k * 1024); } while (0)
#define PG8_LDB(dst, b, h) do { _Pragma("unroll") for (int n = 0; n < 2; ++n) _Pragma("unroll") for (int k = 0; k < 2; ++k) dst[n][k] = *(const PG8_LAS bf16x8*)(lds + PG8_SB(b, h) + boff + n * 2048 + k * 1024); } while (0)
#define PG8_MMA(ai, bj, At, Bt) do { __builtin_amdgcn_s_setprio(1); _Pragma("unroll") for (int m = 0; m < 4; ++m) _Pragma("unroll") for (int n = 0; n < 2; ++n) _Pragma("unroll") for (int k = 0; k < 2; ++k) \
        acc[ai][bj][m][n] = __builtin_amdgcn_mfma_f32_16x16x32_bf16(Bt[n][k], At[m][k], acc[ai][bj][m][n], 0, 0, 0); __builtin_amdgcn_s_setprio(0); } while (0)
#define PG8_WAIT_V(n) asm volatile("s_waitcnt vmcnt(" #n ")" ::: "memory")
#define PG8_WAIT_L(n) asm volatile("s_waitcnt lgkmcnt(" #n ")" ::: "memory")
#define PG8_BAR __builtin_amdgcn_s_barrier()
#define PG8_SCHED __builtin_amdgcn_sched_barrier(0)
    Unit cur, nxt; int ui = 0;
    if (!S.next(0, cur)) return;
    f32x4 acc[2][2][4][2];
#pragma unroll
    for (int a = 0; a < 2; ++a)
#pragma unroll
        for (int b = 0; b < 2; ++b)
#pragma unroll
            for (int m = 0; m < 4; ++m)
#pragma unroll
                for (int n = 0; n < 2; ++n) acc[a][b][m][n] = (f32x4){0.f, 0.f, 0.f, 0.f};
    bf16x8 At[4][2], B0[2][2], B1[2][2];
    const char* cA = (const char*)g.A + (size_t)cur.aoff * 2; const char* cB = (const char*)g.Bt + (size_t)cur.boff * 2;
    PG8_STAGE(PG8_SB(0, 0), cB, voffB); PG8_STAGE(PG8_SB(0, 1), cB + hstepB, voffB); PG8_STAGE(PG8_SA(0, 0), cA, voffA); PG8_STAGE(PG8_SA(0, 1), cA + hstepA, voffA);
    if (wr == 1) PG8_BAR;
    PG8_WAIT_V(2); PG8_BAR;
    PG8_STAGE(PG8_SB(1, 0), cB + kstep, voffB); PG8_STAGE(PG8_SA(1, 0), cA + kstepA, voffA); PG8_STAGE(PG8_SB(1, 1), cB + hstepB + kstep, voffB);
    PG8_WAIT_V(6); PG8_BAR;
    for (;;) {
        const bool has_next = S.next(ui + 1, nxt);
        const char* nA = has_next ? (const char*)g.A + (size_t)nxt.aoff * 2 : cA; const char* nB = has_next ? (const char*)g.Bt + (size_t)nxt.boff * 2 : cB;
#pragma nounroll
        for (int t = 0; t < nt; t += 2) {
            const bool last = (t == nt - 2);
            const char* a1 = cA + (size_t)(t + 1) * kstepA;
            const char* a2 = last ? nA : cA + (size_t)(t + 2) * kstepA; const char* b2 = last ? nB : cB + (size_t)(t + 2) * kstep;
            const char* a3 = a2 + kstepA; const char* b3 = b2 + kstep;
            if constexpr (epi_has_hook<Epi>::value) { if (t == nt / 2) E.hook(acc, cur, wr, wc, fr, fq); }
            PG8_LDB(B0, 0, 0); PG8_LDB(B1, 0, 1); PG8_SCHED; PG8_LDA(At, 0, 0); PG8_STAGE(PG8_SA(1, 1), a1 + hstepA, voffA);
            PG8_WAIT_V(8); PG8_WAIT_L(0); PG8_BAR; PG8_MMA(0, 0, At, B0); PG8_MMA(0, 1, At, B1); PG8_BAR; PG8_SCHED;
            PG8_LDA(At, 0, 1); PG8_STAGE(PG8_SB(0, 0), b2, voffB); PG8_STAGE(PG8_SB(0, 1), b2 + hstepB, voffB); PG8_STAGE(PG8_SA(0, 0), a2, voffA);
            PG8_WAIT_V(8); PG8_WAIT_L(0); PG8_BAR; PG8_MMA(1, 0, At, B0); PG8_MMA(1, 1, At, B1); PG8_BAR; PG8_SCHED;
            PG8_LDB(B0, 1, 0); PG8_LDB(B1, 1, 1); PG8_SCHED; PG8_LDA(At, 1, 0); PG8_STAGE(PG8_SA(0, 1), a2 + hstepA, voffA);
            PG8_WAIT_V(8); PG8_WAIT_L(0); PG8_BAR; PG8_MMA(0, 0, At, B0); PG8_MMA(0, 1, At, B1); PG8_BAR; PG8_SCHED;
            PG8_LDA(At, 1, 1); PG8_STAGE(PG8_SB(1, 0), b3, voffB); PG8_STAGE(PG8_SB(1, 1), b3 + hstepB, voffB); PG8_STAGE(PG8_SA(1, 0), a3, voffA);
            PG8_WAIT_V(8); PG8_WAIT_L(0); PG8_BAR; PG8_MMA(1, 0, At, B0); PG8_MMA(1, 1, At, B1); PG8_BAR; PG8_SCHED;
        }
        if (wr == 0) PG8_BAR;
        E(acc, cur, wr, wc, fr, fq);
        if (!has_next) break;
#pragma unroll
        for (int a = 0; a < 2; ++a)
#pragma unroll
            for (int b = 0; b < 2; ++b)
#pragma unroll
                for (int m = 0; m < 4; ++m)
#pragma unroll
                    for (int n = 0; n < 2; ++n) acc[a][b][m][n] = (f32x4){0.f, 0.f, 0.f, 0.f};
        cur = nxt; cA = nA; cB = nB; ++ui;
        if (wr == 1) PG8_BAR;
    }
    PG8_WAIT_V(0);
    PG8_BAR;
#undef PG8_SA
#undef PG8_SB
#undef PG8_STAGE
#undef PG8_LDA
#undef PG8_LDB
#undef PG8_MMA
#undef PG8_WAIT_V
#undef PG8_WAIT_L
#undef PG8_BAR
#undef PG8_SCHED
}
}

using pg8::bf16_t; using pg8::bf16x8; using pg8::f32x4; using pg8::u32x4; using pg8::u32x2;
using pg8::cvt_pk_bf16; using pg8::bf2f; using pg8::fsigmoid;

constexpr int M = 65536, DM = 1024, DFF = 2816, SEQ = 8192;
constexpr size_t MiB = 1u << 20;
constexpr size_t WS_L = 0, WS_CB = 64 * 1024;
constexpr size_t WS_W1GU = 1 * MiB, WS_W1D = 12 * MiB, WS_W2GU = 18 * MiB, WS_W2D = 29 * MiB, WS_WIN = 35 * MiB, WS_WC1 = 44 * MiB, WS_WC2 = 46 * MiB,
                 WS_WUA = 47 * MiB, WS_WUB = 48 * MiB, WS_WOUT = 49 * MiB, WS_WXQ = 51 * MiB, WS_WXKV = 53 * MiB, WS_WXO = 57 * MiB;
constexpr size_t WS_OA = 65 * MiB, WS_XN = 321 * MiB, WS_R = 449 * MiB;
constexpr size_t WS_H = WS_R, WS_PQ = WS_R, WS_PG = 737 * MiB, WS_MERGED = WS_R, WS_QX = WS_R, WS_PX = 577 * MiB, WS_OX = 705 * MiB;
constexpr size_t WS_MEMN = 993 * MiB, WS_KM = 997 * MiB, WS_VMT = 1001 * MiB, WS_SS = 1005 * MiB, WS_LP = 1017 * MiB, WS_END = 1021 * MiB;
constexpr size_t DO_ACMP = 0, DO_HC = 64 * MiB, DO_KC = 72 * MiB, DO_VCT = 73 * MiB, DO_KVS = 80 * MiB, DO_KVW = 112 * MiB, DO_KVB = 144 * MiB, DO_T = 0;
constexpr int PQ_LD = 2304, PG_LD = 2048;
constexpr int BAR_LDS_OFF = 147456 - 16;
constexpr size_t BAR_BYTES = 16384;
constexpr float LOG2E = 1.4426950408889634f;

__device__ __forceinline__ int t5_bucket(int d) {
    if (d < 16) return d;
    int bk = 16;
    bk += d >= 19; bk += d >= 21; bk += d >= 24; bk += d >= 27; bk += d >= 31; bk += d >= 35; bk += d >= 40; bk += d >= 46;
    bk += d >= 52; bk += d >= 59; bk += d >= 67; bk += d >= 77; bk += d >= 87; bk += d >= 99; bk += d >= 113;
    return bk;
}

#define PROBE_ATT_A 1
#define REP_CMP 1
#define REP_TOPK 1
#define REP_SEL 1
#define REP_WIN 1
#define PROBE_ATT_B 1
struct Params { const float* in[29]; float* out; unsigned char* ws; };

__device__ __forceinline__ float wave_sum(float v) {
#pragma unroll
    for (int o = 1; o < 64; o <<= 1) v += __shfl_xor(v, o);
    return v;
}
__device__ __forceinline__ void conv_item(const float* W, int K, int N, bf16_t* WT, int ldd, int kofs, int kind, int roff, const float* gk, float* scr, int item, int lane) {
    const int nblk = (N + 31) / 32, kb = item / nblk, nb = item % nblk, k0 = 64 * kb, n0 = 32 * nb;
    const int nr = n0 + (lane & 31);
    float wv[32];
#pragma unroll
    for (int i = 0; i < 32; ++i) { const int kk = 2 * i + (lane >> 5); wv[i] = (nr < N) ? W[(size_t)(k0 + kk) * N + nr] : 0.f; }
#pragma unroll
    for (int i = 0; i < 32; ++i) { const int kk = 2 * i + (lane >> 5); scr[kk * 33 + (lane & 31)] = wv[i]; }
    asm volatile("s_waitcnt lgkmcnt(0)" ::: "memory");
    const int c = lane & 7;
#pragma unroll
    for (int j = 0; j < 4; ++j) {
        const int nl = (lane >> 3) + 8 * j, n = n0 + nl; const float* s = scr + (8 * c) * 33 + nl;
        int dr = n + roff; float sc = 1.0f;
        if (kind == 1) dr = (n >> 7) * 256 + (n & 127);
        else if (kind == 2) dr = (n >> 7) * 256 + 128 + (n & 127);
        else if (kind == 3) { dr = n < 2072 ? n : n + 232; if (n < 512 || (n >= 1304 && n < 1816)) sc = 0.125f * LOG2E; }
        else if (kind == 4) sc = 0.0625f * LOG2E;
        f32x4 g0 = (f32x4){sc, sc, sc, sc}, g1 = g0;
        if (gk) { g0 = *(const f32x4*)(gk + k0 + 8 * c) * sc; g1 = *(const f32x4*)(gk + k0 + 8 * c + 4) * sc; }
        u32x4 o; o.x = cvt_pk_bf16(s[0 * 33] * g0[0], s[1 * 33] * g0[1]); o.y = cvt_pk_bf16(s[2 * 33] * g0[2], s[3 * 33] * g0[3]); o.z = cvt_pk_bf16(s[4 * 33] * g1[0], s[5 * 33] * g1[1]); o.w = cvt_pk_bf16(s[6 * 33] * g1[2], s[7 * 33] * g1[3]);
        if (n < N) *(u32x4*)(WT + (size_t)dr * ldd + kofs + k0 + 8 * c) = o;
    }
    asm volatile("s_waitcnt lgkmcnt(0)" ::: "memory");
}
__device__ __forceinline__ void rms_row(const float* xrow, const float* g, bf16_t* orow, float* frow, int lane) {
    const f32x4* xr = (const f32x4*)xrow + lane; const f32x4* gr = (const f32x4*)g + lane;
    f32x4 v[4]; float s = 0.f;
#pragma unroll
    for (int j = 0; j < 4; ++j) { v[j] = xr[64 * j]; s += (v[j].x * v[j].x + v[j].y * v[j].y) + (v[j].z * v[j].z + v[j].w * v[j].w); }
    const float rstd = 1.0f / sqrtf(wave_sum(s) * (1.f / 1024.f) + 1e-6f);
#pragma unroll
    for (int j = 0; j < 4; ++j) {
        const f32x4 gg = gr[64 * j]; const f32x4 y = v[j] * rstd * gg;
        if (orow) { u32x2 w; w.x = cvt_pk_bf16(y.x, y.y); w.y = cvt_pk_bf16(y.z, y.w); *((u32x2*)orow + lane + 64 * j) = w; }
        else *((f32x4*)frow + lane + 64 * j) = y;
    }
}
__device__ __forceinline__ void rms_row_bf16(const bf16_t* xrow, const float* g, float* frow, int lane) {
    float v[2][8]; float s = 0.f;
#pragma unroll
    for (int j = 0; j < 2; ++j) { const u32x4 gw = *((const u32x4*)xrow + lane + 64 * j);
        v[j][0] = __uint_as_float(gw.x << 16); v[j][1] = __uint_as_float(gw.x & 0xffff0000u); v[j][2] = __uint_as_float(gw.y << 16); v[j][3] = __uint_as_float(gw.y & 0xffff0000u);
        v[j][4] = __uint_as_float(gw.z << 16); v[j][5] = __uint_as_float(gw.z & 0xffff0000u); v[j][6] = __uint_as_float(gw.w << 16); v[j][7] = __uint_as_float(gw.w & 0xffff0000u);
#pragma unroll
        for (int e = 0; e < 8; ++e) s += v[j][e] * v[j][e]; }
    const float rstd = 1.0f / sqrtf(wave_sum(s) * (1.f / 1024.f) + 1e-6f);
#pragma unroll
    for (int j = 0; j < 2; ++j) {
        const f32x4 g0 = *((const f32x4*)g + 2 * (lane + 64 * j)), g1 = *((const f32x4*)g + 2 * (lane + 64 * j) + 1);
        *((f32x4*)frow + 2 * (lane + 64 * j)) = (f32x4){v[j][0] * rstd * g0[0], v[j][1] * rstd * g0[1], v[j][2] * rstd * g0[2], v[j][3] * rstd * g0[3]};
        *((f32x4*)frow + 2 * (lane + 64 * j) + 1) = (f32x4){v[j][4] * rstd * g1[0], v[j][5] * rstd * g1[1], v[j][6] * rstd * g1[2], v[j][7] * rstd * g1[3]};
    }
}
__device__ __forceinline__ void rms_pass(const float* X, const float* g, bf16_t* O, float* F, int rows, int gw, int NGW) {
    int tid_ = threadIdx.x; asm volatile("" : "+v"(tid_)); const int lane = tid_ & 63;
    const f32x4* gr = (const f32x4*)g + lane;
    for (int m = gw; m < rows; m += 2 * NGW) {
        const bool two = (m + NGW) < rows; const int m1 = two ? m + NGW : m;
        const f32x4* x0 = (const f32x4*)(X + (size_t)m * 1024) + lane; const f32x4* x1 = (const f32x4*)(X + (size_t)m1 * 1024) + lane;
        f32x4 v0[4], v1[4]; float s0 = 0.f, s1 = 0.f;
#pragma unroll
        for (int j = 0; j < 4; ++j) { v0[j] = x0[64 * j]; v1[j] = x1[64 * j]; }
#pragma unroll
        for (int j = 0; j < 4; ++j) { s0 += (v0[j].x * v0[j].x + v0[j].y * v0[j].y) + (v0[j].z * v0[j].z + v0[j].w * v0[j].w); s1 += (v1[j].x * v1[j].x + v1[j].y * v1[j].y) + (v1[j].z * v1[j].z + v1[j].w * v1[j].w); }
        const float r0 = 1.0f / sqrtf(wave_sum(s0) * (1.f / 1024.f) + 1e-6f), r1 = 1.0f / sqrtf(wave_sum(s1) * (1.f / 1024.f) + 1e-6f);
#pragma unroll
        for (int j = 0; j < 4; ++j) {
            const f32x4 gg = gr[64 * j]; const f32x4 y0 = v0[j] * r0 * gg, y1 = v1[j] * r1 * gg;
            u32x2 w0, w1; w0.x = cvt_pk_bf16(y0.x, y0.y); w0.y = cvt_pk_bf16(y0.z, y0.w); w1.x = cvt_pk_bf16(y1.x, y1.y); w1.y = cvt_pk_bf16(y1.z, y1.w);
            *((u32x2*)(O + (size_t)m * 1024) + lane + 64 * j) = w0;
            if (two) *((u32x2*)(O + (size_t)m1 * 1024) + lane + 64 * j) = w1;
        }
    }
}
__device__ __forceinline__ void rms_final(const bf16_t* X, const float* g, float* out, int rows, int gw, int NGW) {
    int tid_ = threadIdx.x; asm volatile("" : "+v"(tid_)); const int lane = tid_ & 63;
    for (int m = gw; m < rows; m += 4 * NGW) {
        u32x4 raw[4][2];
#pragma unroll
        for (int k = 0; k < 4; ++k) { const int mk = (m + k * NGW) < rows ? m + k * NGW : m;
#pragma unroll
            for (int j = 0; j < 2; ++j) raw[k][j] = *((const u32x4*)(X + (size_t)mk * 1024) + lane + 64 * j); }
#pragma unroll
        for (int k = 0; k < 4; ++k) {
            float v[2][8]; float sq = 0.f;
#pragma unroll
            for (int j = 0; j < 2; ++j) { const u32x4 gw4 = raw[k][j];
                v[j][0] = __uint_as_float(gw4.x << 16); v[j][1] = __uint_as_float(gw4.x & 0xffff0000u); v[j][2] = __uint_as_float(gw4.y << 16); v[j][3] = __uint_as_float(gw4.y & 0xffff0000u);
                v[j][4] = __uint_as_float(gw4.z << 16); v[j][5] = __uint_as_float(gw4.z & 0xffff0000u); v[j][6] = __uint_as_float(gw4.w << 16); v[j][7] = __uint_as_float(gw4.w & 0xffff0000u);
#pragma unroll
                for (int e = 0; e < 8; ++e) sq += v[j][e] * v[j][e]; }
            const float rstd = 1.0f / sqrtf(wave_sum(sq) * (1.f / 1024.f) + 1e-6f);
            if ((m + k * NGW) < rows) {
                float* frow = out + (size_t)(m + k * NGW) * 1024;
#pragma unroll
                for (int j = 0; j < 2; ++j) {
                    const f32x4 g0 = *((const f32x4*)g + 2 * (lane + 64 * j)), g1 = *((const f32x4*)g + 2 * (lane + 64 * j) + 1);
                    *((f32x4*)frow + 2 * (lane + 64 * j)) = (f32x4){v[j][0] * rstd * g0[0], v[j][1] * rstd * g0[1], v[j][2] * rstd * g0[2], v[j][3] * rstd * g0[3]};
                    *((f32x4*)frow + 2 * (lane + 64 * j) + 1) = (f32x4){v[j][4] * rstd * g1[0], v[j][5] * rstd * g1[1], v[j][6] * rstd * g1[2], v[j][7] * rstd * g1[3]};
                }
            }
        }
    }
}

namespace att {
constexpr int SLOTB = 16384, NSLOT = 4;
constexpr int OFF_RING = 0, OFF_BT = NSLOT * SLOTB, OFF_SEL = OFF_BT + 129 * 16 * 4 + 192, OFF_IMP = OFF_SEL + 64 * 4 * 4, IMP_LD = 129, OFF_STASH = OFF_IMP, ATT_LDS = OFF_STASH + 32 * 512 * 4;
static_assert(OFF_IMP % 16 == 0 && 64 * IMP_LD * 4 <= 32 * 512 * 4 && ATT_LDS <= 147456, "attention LDS map");
struct Args { const bf16_t* PQ; const bf16_t* KC; const bf16_t* VCT; const bf16_t* KVS; const bf16_t* KVW; const bf16_t* KVB; bf16_t* OA; bf16_t* OB; const float* sinks; };

__device__ __forceinline__ int prow(int f, int r) { return 32 * (f >> 1) + 8 * (r >> 2) + 4 * (f & 1) + (r & 3); }
__device__ __forceinline__ int swz(int R) { return (R & 2) | ((R & 8) >> 1); }
__device__ __forceinline__ unsigned src_off(int w, int lane, int ldB) { const int R = 8 * w + (lane >> 3), cch = (lane & 7) ^ swz(R); return (unsigned)(R * ldB + cch * 16); }
__device__ __forceinline__ void glds16(const void* gsrc, unsigned lds_dst) { unsigned keep;
    asm volatile("s_mov_b32 %0, m0\n\ts_mov_b32 m0, %2\n\ts_nop 0\n\tglobal_load_lds_dwordx4 %1, off\n\ts_mov_b32 m0, %0" : "=&s"(keep) : "v"(gsrc), "s"(lds_dst) : "memory"); }
__device__ __forceinline__ void dma_block(PG8_LAS unsigned char* lds3, int slot, int wu, const unsigned char* Kblk, unsigned koff, const unsigned char* Vblk, unsigned voff) {
    const unsigned base = (unsigned)(__UINTPTR_TYPE__)lds3 + OFF_RING + slot * SLOTB + wu * 1024;
    glds16(Kblk + koff, (unsigned)__builtin_amdgcn_readfirstlane(base));
    glds16(Vblk + voff, (unsigned)__builtin_amdgcn_readfirstlane(base + 8192));
}
__device__ __forceinline__ void ring_wait_bar(int young) {
    if (young >= 2) asm volatile("s_waitcnt vmcnt(4)" ::: "memory"); else if (young == 1) asm volatile("s_waitcnt vmcnt(2)" ::: "memory"); else asm volatile("s_waitcnt vmcnt(0)" ::: "memory");
    asm volatile("s_waitcnt lgkmcnt(0)" ::: "memory");
    __builtin_amdgcn_s_barrier();
    asm volatile("" ::: "memory");
}
__device__ __forceinline__ void load_kfrags(bf16x8 (&kf)[4][2], const unsigned char* Ks, int r, int fq) {
#pragma unroll
    for (int f = 0; f < 4; ++f)
#pragma unroll
        for (int dc = 0; dc < 2; ++dc) { const int R = prow(f, r); kf[f][dc] = *(const bf16x8*)(Ks + R * 128 + (((4 * dc + fq) ^ swz(R)) << 4)); }
}
__device__ __forceinline__ void qk(f32x4 (&s)[4], const bf16x8 (&kf)[4][2], const bf16x8 (&q)[2], float cinit) {
#pragma unroll
    for (int f = 0; f < 4; ++f) {
        s[f] = (f32x4){cinit, cinit, cinit, cinit};
#pragma unroll
        for (int dc = 0; dc < 2; ++dc) s[f] = __builtin_amdgcn_mfma_f32_16x16x32_bf16(kf[f][dc], q[dc], s[f], 0, 0, 0);
    }
}
__device__ __forceinline__ void pv(f32x4 (&o)[4], const float (&p)[4][4], const unsigned char* Vs, int r, int fq) {
    bf16x8 pb[2];
#pragma unroll
    for (int kc = 0; kc < 2; ++kc) {
        u32x4 w; w.x = cvt_pk_bf16(p[2 * kc][0], p[2 * kc][1]); w.y = cvt_pk_bf16(p[2 * kc][2], p[2 * kc][3]); w.z = cvt_pk_bf16(p[2 * kc + 1][0], p[2 * kc + 1][1]); w.w = cvt_pk_bf16(p[2 * kc + 1][2], p[2 * kc + 1][3]);
        pb[kc] = __builtin_bit_cast(bf16x8, w);
    }
#pragma unroll
    for (int df = 0; df < 4; ++df)
#pragma unroll
        for (int kc = 0; kc < 2; ++kc) {
            const int R = prow(df, r);
            const bf16x8 vf = *(const bf16x8*)(Vs + R * 128 + (((4 * kc + fq) ^ swz(R)) << 4));
            o[df] = __builtin_amdgcn_mfma_f32_16x16x32_bf16(vf, pb[kc], o[df], 0, 0, 0);
        }
}
__device__ __forceinline__ void logits(float (&v)[4][4], const f32x4 (&s)[4], int tq, int kpos0, int kstride, int fq, int H, const float* btab, float farb, bool use_tab, int wl) {
#pragma unroll
    for (int f = 0; f < 4; ++f)
#pragma unroll
        for (int i = 0; i < 4; ++i) {
            const int kk = 32 * (f >> 1) + 8 * fq + 4 * (f & 1) + i;
            const int dist = tq - (kpos0 + kstride * kk);
            const bool ok = dist >= 0 && dist < wl;
            const int di = dist < 0 ? 0 : (dist > 128 ? 128 : dist);
            v[f][i] = ok ? s[f][i] + btab[di * 16 + H] : -1e30f;
        }
}
__device__ __forceinline__ float red_max4(float x) {
    auto a = __builtin_amdgcn_permlane16_swap(__float_as_uint(x), __float_as_uint(x), false, false); x = fmaxf(__uint_as_float(a[0]), __uint_as_float(a[1]));
    auto b = __builtin_amdgcn_permlane32_swap(__float_as_uint(x), __float_as_uint(x), false, false); return fmaxf(__uint_as_float(b[0]), __uint_as_float(b[1]));
}
__device__ __forceinline__ float quad_sum(float x) {
    auto a = __builtin_amdgcn_permlane16_swap(__float_as_uint(x), __float_as_uint(x), false, false); x = __uint_as_float(a[0]) + __uint_as_float(a[1]);
    auto b = __builtin_amdgcn_permlane32_swap(__float_as_uint(x), __float_as_uint(x), false, false); return __uint_as_float(b[0]) + __uint_as_float(b[1]);
}
__device__ __forceinline__ float dpp_xor1(float x) { return __builtin_bit_cast(float, __builtin_amdgcn_update_dpp(0, __builtin_bit_cast(int, x), 0xB1, 0xF, 0xF, true)); }
__device__ __forceinline__ float dpp_xor2(float x) { return __builtin_bit_cast(float, __builtin_amdgcn_update_dpp(0, __builtin_bit_cast(int, x), 0x4E, 0xF, 0xF, true)); }
__device__ __forceinline__ float max16(const float (&v)[4][4]) {
    float a = fmaxf(fmaxf(v[0][0], v[0][1]), fmaxf(v[0][2], v[0][3])), b = fmaxf(fmaxf(v[1][0], v[1][1]), fmaxf(v[1][2], v[1][3]));
    float c = fmaxf(fmaxf(v[2][0], v[2][1]), fmaxf(v[2][2], v[2][3])), d = fmaxf(fmaxf(v[3][0], v[3][1]), fmaxf(v[3][2], v[3][3]));
    return fmaxf(fmaxf(a, b), fmaxf(c, d));
}
__device__ __forceinline__ float max3f(float a, float b, float c) { float r; asm("v_max3_f32 %0, %1, %2, %3" : "=v"(r) : "v"(a), "v"(b), "v"(c)); return r; }
__device__ __forceinline__ float max16v(const f32x4 (&s)[4]) {
    float a = max3f(s[0][0], s[0][1], s[0][2]), b = max3f(s[0][3], s[1][0], s[1][1]), c = max3f(s[1][2], s[1][3], s[2][0]), d = max3f(s[2][1], s[2][2], s[2][3]);
    a = max3f(a, s[3][0], s[3][1]); b = max3f(b, s[3][2], s[3][3]); return max3f(max3f(a, b, c), d, d);
}
template <int CGM>
__device__ __forceinline__ void pv2(f32x4 (&o)[2][4], const float (&p)[2][4][4], const unsigned char* Vs, int r, int fq) {
    bf16x8 pb[2][2];
#pragma unroll
    for (int cg_ = 0; cg_ < 2; ++cg_) if ((CGM >> cg_) & 1)
#pragma unroll
        for (int kc = 0; kc < 2; ++kc) {
            u32x4 w; w.x = cvt_pk_bf16(p[cg_][2 * kc][0], p[cg_][2 * kc][1]); w.y = cvt_pk_bf16(p[cg_][2 * kc][2], p[cg_][2 * kc][3]);
            w.z = cvt_pk_bf16(p[cg_][2 * kc + 1][0], p[cg_][2 * kc + 1][1]); w.w = cvt_pk_bf16(p[cg_][2 * kc + 1][2], p[cg_][2 * kc + 1][3]);
            pb[cg_][kc] = __builtin_bit_cast(bf16x8, w);
        }
#pragma unroll
    for (int df = 0; df < 4; ++df)
#pragma unroll
        for (int kc = 0; kc < 2; ++kc) {
            const int R = prow(df, r);
            const bf16x8 vf = *(const bf16x8*)(Vs + R * 128 + (((4 * kc + fq) ^ swz(R)) << 4));
            if (CGM & 1) o[0][df] = __builtin_amdgcn_mfma_f32_16x16x32_bf16(vf, pb[0][kc], o[0][df], 0, 0, 0);
            if (CGM & 2) o[1][df] = __builtin_amdgcn_mfma_f32_16x16x32_bf16(vf, pb[1][kc], o[1][df], 0, 0, 0);
        }
}
template <int CGM>
__device__ __forceinline__ void step_edge(const bf16x8 (&kf)[4][2], const bf16x8 (&q)[2][2], const int (&tq)[2], int key0, int fq, int H, const float* btab, int wl, const bool (&selq)[2],
                                          float (&m)[2], float (&l)[2], f32x4 (&o)[2][4], const unsigned char* Vs, int r) {
    float v[2][4][4]; float mnew[2] = {m[0], m[1]};
#pragma unroll
    for (int cg_ = 0; cg_ < 2; ++cg_) if ((CGM >> cg_) & 1) {
        f32x4 s[4]; qk(s, kf, q[cg_], 0.f); logits(v[cg_], s, tq[cg_], key0, 1, fq, H, btab, 0.f, true, wl);
        float mx = red_max4(max16(v[cg_])); if (!selq[cg_]) mx = -1e30f; mnew[cg_] = fmaxf(m[cg_], mx);
    }
    if (__any(mnew[0] > m[0] || mnew[1] > m[1])) {
#pragma unroll
        for (int cg_ = 0; cg_ < 2; ++cg_) if ((CGM >> cg_) & 1) {
            const float sc = __builtin_amdgcn_exp2f(m[cg_] - mnew[cg_]); l[cg_] *= sc; m[cg_] = mnew[cg_];
#pragma unroll
            for (int df = 0; df < 4; ++df) o[cg_][df] *= sc;
        }
    }
#pragma unroll
    for (int cg_ = 0; cg_ < 2; ++cg_) if ((CGM >> cg_) & 1) {
        const float moff = selq[cg_] ? m[cg_] : 1e30f; float rs = 0.f;
#pragma unroll
        for (int f = 0; f < 4; ++f)
#pragma unroll
            for (int i = 0; i < 4; ++i) { const float pe = __builtin_amdgcn_exp2f(v[cg_][f][i] - moff); v[cg_][f][i] = pe; rs += pe; }
        l[cg_] += rs;
    }
    pv2<CGM>(o, v, Vs, r, fq);
}
template <int CGM>
__device__ __forceinline__ void step_int(const bf16x8 (&kf)[4][2], const bf16x8 (&q)[2][2], float farb, const bool (&selq)[2],
                                         float (&m)[2], float (&l)[2], f32x4 (&o)[2][4], const unsigned char* Vs, int r, int fq) {
    f32x4 s[2][4]; float mx[2] = {-1e30f, -1e30f};
#pragma unroll
    for (int cg_ = 0; cg_ < 2; ++cg_) if ((CGM >> cg_) & 1) { qk(s[cg_], kf, q[cg_], selq[cg_] ? farb - m[cg_] : -1e30f); mx[cg_] = red_max4(max16v(s[cg_])); }
    if (__any(mx[0] > 0.f || mx[1] > 0.f)) {
#pragma unroll
        for (int cg_ = 0; cg_ < 2; ++cg_) if ((CGM >> cg_) & 1) {
            const float d = fmaxf(mx[cg_], 0.f), sc = __builtin_amdgcn_exp2f(-d); m[cg_] += d; l[cg_] *= sc;
#pragma unroll
            for (int df = 0; df < 4; ++df) o[cg_][df] *= sc;
#pragma unroll
            for (int f = 0; f < 4; ++f) s[cg_][f] -= d;
        }
    }
    float p[2][4][4];
#pragma unroll
    for (int cg_ = 0; cg_ < 2; ++cg_) if ((CGM >> cg_) & 1) {
        float rs = 0.f;
#pragma unroll
        for (int f = 0; f < 4; ++f)
#pragma unroll
            for (int i = 0; i < 4; ++i) { const float pe = __builtin_amdgcn_exp2f(s[cg_][f][i]); p[cg_][f][i] = pe; rs += pe; }
        l[cg_] += rs;
    }
    pv2<CGM>(o, p, Vs, r, fq);
}

template <bool SEL>
__device__ __forceinline__ void band_loop(unsigned char* lds, PG8_LAS unsigned char* lds3, const unsigned char* KV, int jhi, int jlo, int T, int wl,
                                          const bf16x8 (&q)[2][2], const int (&tq)[2], const unsigned long long (&sw)[2][2], int H, float farb,
                                          float (&m)[2], float (&l)[2], f32x4 (&o)[2][4], int wu, unsigned soff, int r, int fq) {
    const float* btab = (const float*)(lds + OFF_BT);
    const int n = jhi - jlo + 1;
    __syncthreads();
#pragma unroll
    for (int pi = 0; pi < 2; ++pi) if (pi < n) { const unsigned char* blk = KV + (size_t)(jhi - pi) * SLOTB; dma_block(lds3, pi, wu, blk, soff, blk + 8192, soff); }
    for (int it0 = 0; it0 < n; it0 += 2) {
        ring_wait_bar(0);
#pragma unroll
        for (int pi = 2; pi < 4; ++pi) if (it0 + pi < n) { const unsigned char* blk = KV + (size_t)(jhi - it0 - pi) * SLOTB; dma_block(lds3, (it0 + pi) & 3, wu, blk, soff, blk + 8192, soff); }
#pragma unroll 1
        for (int it = it0; it < it0 + 2 && it < n; ++it) {
            const int j = jhi - it, slot = it & 3;
            bool selq[2] = {true, true}; bool any[2] = {true, true};
            if (SEL) {
#pragma unroll
                for (int cg_ = 0; cg_ < 2; ++cg_) {
                    const unsigned long long wsel = j < 64 ? sw[cg_][0] : sw[cg_][1];
                    selq[cg_] = ((wsel >> (j & 63)) & 1ull) != 0ull; any[cg_] = __any(selq[cg_]) != 0;
                }
            }
            if (any[0] || any[1]) {
                const unsigned char* Ks = lds + OFF_RING + slot * SLOTB; const unsigned char* Vs = Ks + 8192;
                bf16x8 kf[4][2]; load_kfrags(kf, Ks, r, fq);
                const bool edge = (j >= T - 2) || (wl == 512 && j == T - 8);
                if (edge) {
                    if (any[0] && any[1]) step_edge<3>(kf, q, tq, j * 64, fq, H, btab, wl, selq, m, l, o, Vs, r);
                    else if (any[0]) step_edge<1>(kf, q, tq, j * 64, fq, H, btab, wl, selq, m, l, o, Vs, r);
                    else step_edge<2>(kf, q, tq, j * 64, fq, H, btab, wl, selq, m, l, o, Vs, r);
                } else {
                    if (any[0] && any[1]) step_int<3>(kf, q, farb, selq, m, l, o, Vs, r, fq);
                    else if (any[0]) step_int<1>(kf, q, farb, selq, m, l, o, Vs, r, fq);
                    else step_int<2>(kf, q, farb, selq, m, l, o, Vs, r, fq);
                }
            }
        }
    }
}

__device__ __forceinline__ void unitA(unsigned char* lds, PG8_LAS unsigned char* lds3, const Args& a, int b, int g, int T) {
    int tid = threadIdx.x; asm volatile("" : "+v"(tid));
    const int w = tid >> 6, wu = __builtin_amdgcn_readfirstlane(w), lane = tid & 63, c = lane & 15, fq = lane >> 4, hl = c & 3, r = c;
    const int H = 4 * g + hl, t0 = T * 64, bg = b * 2 + g;
    float* btab = (float*)(lds + OFF_BT); float* imp = (float*)(lds + OFF_IMP); unsigned* selm = (unsigned*)(lds + OFF_SEL);
    int tq[2]; bf16x8 q[2][2];
    f32x4* stash = (f32x4*)(lds + OFF_STASH);
#pragma unroll
    for (int cg_ = 0; cg_ < 2; ++cg_) {
        tq[cg_] = t0 + 8 * w + 4 * cg_ + (c >> 2);
        const bf16_t* rowp = a.PQ + (size_t)(b * SEQ + tq[cg_]) * PQ_LD;
#pragma unroll
        for (int dc = 0; dc < 2; ++dc) q[cg_][dc] = *(const bf16x8*)(rowp + H * 64 + 32 * dc + 8 * fq);
    }
#pragma unroll
    for (int cg_ = 0; cg_ < 2; ++cg_)
#pragma unroll
        for (int dc = 0; dc < 2; ++dc) asm volatile("" : "+v"(q[cg_][dc]));
    float gatev[3][2];
#pragma unroll
    for (int cg_ = 0; cg_ < 2; ++cg_)
#pragma unroll
        for (int br = 0; br < 3; ++br) { gatev[br][cg_] = bf2f(a.PQ[(size_t)(b * SEQ + tq[cg_]) * PQ_LD + 1280 + br * 8 + H]); asm volatile("" : "+v"(gatev[br][cg_])); }
#define GATE(br, cg_) fsigmoid(gatev[br][cg_])
    const float farb = btab[128 * 16 + H];
    const unsigned soff = src_off(w, lane, 128);
    __syncthreads();
    for (int i = tid; i < 64 * IMP_LD; i += 512) imp[i] = 0.f;
    f32x4 oc[2][4];
    for (int rep_ = 0; rep_ < REP_CMP; ++rep_) {
        const int NB = ((4 * T + 2) >> 6) + 1;
        const int ib_far = (64 * T - 1167) >= 0 ? (64 * T - 1167) / 1024 : -1;
        const unsigned char* Kb = (const unsigned char*)(a.KC + (size_t)bg * 512 * 64); const unsigned char* Vb = (const unsigned char*)(a.VCT + (size_t)bg * 64 * 512);
        const unsigned voffc = src_off(w, lane, 1024);
        float m[2] = {-1e30f, -1e30f}, l[2] = {0.f, 0.f}, moff[2];
        __syncthreads();
#pragma unroll
        for (int pi = 0; pi < 3; ++pi) if (pi < NB) dma_block(lds3, pi, wu, Kb + (size_t)pi * 8192, soff, Vb + pi * 128, voffc);
        for (int ib = 0; ib < NB; ++ib) {
            ring_wait_bar(NB - 1 - ib);
            if (ib + 3 < NB) dma_block(lds3, (ib + 3) & 3, wu, Kb + (size_t)(ib + 3) * 8192, soff, Vb + (ib + 3) * 128, voffc);
            const unsigned char* Ks = lds + OFF_RING + (ib & 3) * SLOTB;
            bf16x8 kf[4][2]; load_kfrags(kf, Ks, r, fq);
            const bool edge = ib > ib_far;
#pragma unroll
            for (int cg_ = 0; cg_ < 2; ++cg_) {
                f32x4 s[4]; float v[4][4];
                if (edge) { qk(s, kf, q[cg_], 0.f); logits(v, s, tq[cg_], 16 * 64 * ib + 31, 16, fq, H, btab, farb, true, 1 << 30); }
                else { qk(s, kf, q[cg_], farb);
#pragma unroll
                    for (int f = 0; f < 4; ++f)
#pragma unroll
                        for (int i = 0; i < 4; ++i) v[f][i] = s[f][i]; }
                const float mx = red_max4(max16(v)), mnew = fmaxf(m[cg_], mx), sc = __builtin_amdgcn_exp2f(m[cg_] - mnew); m[cg_] = mnew;
                float rs = 0.f;
#pragma unroll
                for (int f = 0; f < 4; ++f)
#pragma unroll
                    for (int i = 0; i < 4; ++i) rs += v[f][i] > -1e29f ? __builtin_amdgcn_exp2f(v[f][i] - mnew) : 0.f;
                l[cg_] = l[cg_] * sc + rs;
            }
        }
#pragma unroll
        for (int cg_ = 0; cg_ < 2; ++cg_) { const float lt = quad_sum(l[cg_]); moff[cg_] = lt > 0.f ? m[cg_] + __builtin_amdgcn_logf(lt) : 1e30f; }
#pragma unroll
        for (int cg_ = 0; cg_ < 2; ++cg_)
#pragma unroll
            for (int df = 0; df < 4; ++df) oc[cg_][df] = (f32x4){0.f, 0.f, 0.f, 0.f};
        __syncthreads();
#pragma unroll
        for (int pi = 0; pi < 3; ++pi) if (pi < NB) dma_block(lds3, pi, wu, Kb + (size_t)pi * 8192, soff, Vb + pi * 128, voffc);
        for (int ib = 0; ib < NB; ++ib) {
            ring_wait_bar(NB - 1 - ib);
            if (ib + 3 < NB) dma_block(lds3, (ib + 3) & 3, wu, Kb + (size_t)(ib + 3) * 8192, soff, Vb + (ib + 3) * 128, voffc);
            const unsigned char* Ks = lds + OFF_RING + (ib & 3) * SLOTB; const unsigned char* Vs = Ks + 8192;
            bf16x8 kf[4][2]; load_kfrags(kf, Ks, r, fq);
            const bool edge = ib > ib_far;
#pragma unroll
            for (int cg_ = 0; cg_ < 2; ++cg_) {
                f32x4 s[4]; float v[4][4];
                if (edge) { qk(s, kf, q[cg_], 0.f); logits(v, s, tq[cg_], 16 * 64 * ib + 31, 16, fq, H, btab, farb, true, 1 << 30);
#pragma unroll
                    for (int f = 0; f < 4; ++f)
#pragma unroll
                        for (int i = 0; i < 4; ++i) v[f][i] -= moff[cg_]; }
                else { qk(s, kf, q[cg_], farb - moff[cg_]);
#pragma unroll
                    for (int f = 0; f < 4; ++f)
#pragma unroll
                        for (int i = 0; i < 4; ++i) v[f][i] = s[f][i]; }
                const int qi = 8 * w + 4 * cg_ + (c >> 2);
#pragma unroll
                for (int f = 0; f < 4; ++f) {
#pragma unroll
                    for (int i = 0; i < 4; ++i) v[f][i] = __builtin_amdgcn_exp2f(v[f][i]);
                    float pa = v[f][0] + v[f][1] + v[f][2] + 0.5f * v[f][3], pb = 0.5f * v[f][3];
                    pa += dpp_xor1(pa); pa += dpp_xor2(pa); pb += dpp_xor1(pb); pb += dpp_xor2(pb);
                    if (hl == 0) { const int jj = 16 * ib + 8 * (f >> 1) + 2 * fq + (f & 1); atomicAdd(&imp[qi * IMP_LD + jj], pa); atomicAdd(&imp[qi * IMP_LD + jj + 1], pb); }
                }
                pv(oc[cg_], v, Vs, r, fq);
            }
        }
    }
    __syncthreads();
    for (int rep_ = 0; rep_ < REP_TOPK; ++rep_) {
        const int qi = 8 * w + (lane >> 3), gq = lane & 7;
        unsigned m16 = 0u;
        if (T <= 15) {
#pragma unroll
            for (int i = 0; i < 16; ++i) m16 |= (16 * gq + i <= T) ? (1u << i) : 0u;
        } else {
            unsigned u[16];
#pragma unroll
            for (int i = 0; i < 16; ++i) { const int j = 16 * gq + i; u[i] = (j >= 1 && j <= T - 2) ? __float_as_uint(imp[qi * IMP_LD + j]) : 0u; }
            unsigned thr = 0u;
            for (int bit = 30; bit >= 0; --bit) {
                const unsigned cand = thr | (1u << bit);
                int cnt = 0;
#pragma unroll
                for (int i = 0; i < 16; ++i) cnt += (u[i] >= cand) ? 1 : 0;
                cnt += __builtin_amdgcn_update_dpp(0, cnt, 0xB1, 0xF, 0xF, true); cnt += __builtin_amdgcn_update_dpp(0, cnt, 0x4E, 0xF, 0xF, true); cnt += __builtin_amdgcn_update_dpp(0, cnt, 0x141, 0xF, 0xF, true);
                if (cnt >= 13) thr = cand;
            }
            int ngt = 0, neq = 0;
#pragma unroll
            for (int i = 0; i < 16; ++i) { const int j = 16 * gq + i; ngt += (u[i] > thr) ? 1 : 0; neq += (u[i] == thr && j >= 1 && j <= T - 2) ? 1 : 0; }
            ngt += __builtin_amdgcn_update_dpp(0, ngt, 0xB1, 0xF, 0xF, true); ngt += __builtin_amdgcn_update_dpp(0, ngt, 0x4E, 0xF, 0xF, true); ngt += __builtin_amdgcn_update_dpp(0, ngt, 0x141, 0xF, 0xF, true);
            int before = 0;
#pragma unroll
            for (int g2 = 0; g2 < 7; ++g2) { const int other = __shfl(neq, (lane & ~7) | g2); before += (g2 < gq) ? other : 0; }
            int need = 13 - ngt - before;
#pragma unroll
            for (int i = 0; i < 16; ++i) {
                const int j = 16 * gq + i; bool sel = u[i] > thr;
                if (u[i] == thr && j >= 1 && j <= T - 2) { sel = need > 0; --need; }
                if (j == 0 || j == T - 1 || j == T) sel = true;
                m16 |= sel ? (1u << i) : 0u;
            }
        }
        const unsigned hi = (unsigned)__builtin_amdgcn_update_dpp(0, (int)m16, 0xB1, 0xF, 0xF, true);
        if ((gq & 1) == 0) selm[qi * 4 + (gq >> 1)] = m16 | (hi << 16);
    }
    __syncthreads();
#pragma unroll
    for (int cg_ = 0; cg_ < 2; ++cg_) { const float gsc = GATE(0, cg_);
#pragma unroll
        for (int df = 0; df < 4; ++df) stash[(cg_ * 4 + df) * 512 + tid] = oc[cg_][df] * gsc; }
    unsigned long long sw[2][2];
#pragma unroll
    for (int cg_ = 0; cg_ < 2; ++cg_) { const unsigned* sp = selm + (8 * w + 4 * cg_ + (c >> 2)) * 4;
        sw[cg_][0] = (unsigned long long)sp[0] | ((unsigned long long)sp[1] << 32); sw[cg_][1] = (unsigned long long)sp[2] | ((unsigned long long)sp[3] << 32); }
    for (int rep_ = 0; rep_ < REP_SEL; ++rep_) {
        float m[2] = {-1e30f, -1e30f}, l[2] = {0.f, 0.f}; f32x4 o[2][4];
#pragma unroll
        for (int cg_ = 0; cg_ < 2; ++cg_)
#pragma unroll
            for (int df = 0; df < 4; ++df) o[cg_][df] = (f32x4){0.f, 0.f, 0.f, 0.f};
        band_loop<true>(lds, lds3, (const unsigned char*)a.KVS + (size_t)bg * 128 * SLOTB, T, 0, T, 1 << 30, q, tq, sw, H, farb, m, l, o, wu, soff, r, fq);
        if (rep_ == REP_SEL - 1)
#pragma unroll
        for (int cg_ = 0; cg_ < 2; ++cg_) { const float sc = GATE(1, cg_) / quad_sum(l[cg_]);
#pragma unroll
            for (int df = 0; df < 4; ++df) stash[(cg_ * 4 + df) * 512 + tid] += o[cg_][df] * sc; }
    }
    for (int rep_ = 0; rep_ < REP_WIN; ++rep_) {
        float m[2] = {-1e30f, -1e30f}, l[2] = {0.f, 0.f}; f32x4 o[2][4];
#pragma unroll
        for (int cg_ = 0; cg_ < 2; ++cg_)
#pragma unroll
            for (int df = 0; df < 4; ++df) o[cg_][df] = (f32x4){0.f, 0.f, 0.f, 0.f};
        band_loop<false>(lds, lds3, (const unsigned char*)a.KVW + (size_t)bg * 128 * SLOTB, T, T - 8 > 0 ? T - 8 : 0, T, 512, q, tq, sw, H, farb, m, l, o, wu, soff, r, fq);
        if (rep_ == REP_WIN - 1)
#pragma unroll
        for (int cg_ = 0; cg_ < 2; ++cg_) { const float sc = GATE(2, cg_) / quad_sum(l[cg_]);
            bf16_t* op = a.OA + (size_t)(b * SEQ + tq[cg_]) * 1024 + H * 64 + 8 * fq;
#pragma unroll
            for (int e = 0; e < 2; ++e) {
                const f32x4 x0 = stash[(cg_ * 4 + 2 * e) * 512 + tid] + o[cg_][2 * e] * sc, x1 = stash[(cg_ * 4 + 2 * e + 1) * 512 + tid] + o[cg_][2 * e + 1] * sc;
                u32x4 wv; wv.x = cvt_pk_bf16(x0[0], x0[1]); wv.y = cvt_pk_bf16(x0[2], x0[3]); wv.z = cvt_pk_bf16(x1[0], x1[1]); wv.w = cvt_pk_bf16(x1[2], x1[3]);
                *(u32x4*)(op + 32 * e) = wv;
            }
        }
    }
#undef GATE
}
__device__ __forceinline__ void unitB(unsigned char* lds, PG8_LAS unsigned char* lds3, const Args& a, int b, int kvh, int T) {
    int tid = threadIdx.x; asm volatile("" : "+v"(tid));
    const int w = tid >> 6, wu = __builtin_amdgcn_readfirstlane(w), lane = tid & 63, c = lane & 15, fq = lane >> 4, hl = c & 3, r = c;
    const int hb = 4 * kvh + hl, H = 8 + hb, t0 = T * 64, bg = b * 2 + kvh;
    const float* btab = (const float*)(lds + OFF_BT);
    int tq[2]; bf16x8 q[2][2]; unsigned long long sw[2][2];
#pragma unroll
    for (int cg_ = 0; cg_ < 2; ++cg_) {
        tq[cg_] = t0 + 8 * w + 4 * cg_ + (c >> 2);
        const bf16_t* rowp = a.PQ + (size_t)(b * SEQ + tq[cg_]) * PQ_LD;
#pragma unroll
        for (int dc = 0; dc < 2; ++dc) q[cg_][dc] = *(const bf16x8*)(rowp + 1304 + hb * 64 + 32 * dc + 8 * fq);
        sw[cg_][0] = 0ull; sw[cg_][1] = 0ull;
    }
#pragma unroll
    for (int cg_ = 0; cg_ < 2; ++cg_)
#pragma unroll
        for (int dc = 0; dc < 2; ++dc) asm volatile("" : "+v"(q[cg_][dc]));
    const float farb = btab[128 * 16 + H];
    const unsigned soff = src_off(w, lane, 128);
    float m[2] = {-1e30f, -1e30f}, l[2] = {0.f, 0.f}; f32x4 o[2][4];
#pragma unroll
    for (int cg_ = 0; cg_ < 2; ++cg_)
#pragma unroll
        for (int df = 0; df < 4; ++df) o[cg_][df] = (f32x4){0.f, 0.f, 0.f, 0.f};
    band_loop<false>(lds, lds3, (const unsigned char*)a.KVB + (size_t)bg * 128 * SLOTB, T, T - 2 > 0 ? T - 2 : 0, T, 128, q, tq, sw, H, farb, m, l, o, wu, soff, r, fq);
    const float sink2 = a.sinks[hb] * LOG2E;
#pragma unroll
    for (int cg_ = 0; cg_ < 2; ++cg_) {
        const float lt = quad_sum(l[cg_]) + __builtin_amdgcn_exp2f(sink2 - m[cg_]); const float sc = 1.0f / lt;
        bf16_t* op = a.OB + (size_t)(b * SEQ + tq[cg_]) * 1024 + hb * 64 + 8 * fq;
#pragma unroll
        for (int e = 0; e < 2; ++e) {
            u32x4 wv; wv.x = cvt_pk_bf16(o[cg_][2 * e][0] * sc, o[cg_][2 * e][1] * sc); wv.y = cvt_pk_bf16(o[cg_][2 * e][2] * sc, o[cg_][2 * e][3] * sc);
            wv.z = cvt_pk_bf16(o[cg_][2 * e + 1][0] * sc, o[cg_][2 * e + 1][1] * sc); wv.w = cvt_pk_bf16(o[cg_][2 * e + 1][2] * sc, o[cg_][2 * e + 1][3] * sc);
            *(u32x4*)(op + 32 * e) = wv;
        }
    }
}
}

#define LAS __attribute__((address_space(3)))
#define XB_TMO      128
#define XB_XCNT(j)  (256  + 64 * (j))
#define XB_XSUB(j)  (1280 + 64 * (j))
#define XB_XGEN(j)  (2304 + 64 * (j))
#define XB_TOP      3328
#define XB_TOPGEN   3392
#define XCD_BAR_WORDS 3456
#define XB_SPIN_CAP (1u << 24)

__device__ __forceinline__ unsigned xb_ld(unsigned* p)              { return __hip_atomic_load(p, __ATOMIC_RELAXED, __HIP_MEMORY_SCOPE_AGENT); }
__device__ __forceinline__ unsigned xb_add(unsigned* p, unsigned v) { return __hip_atomic_fetch_add(p, v, __ATOMIC_RELAXED, __HIP_MEMORY_SCOPE_AGENT); }
__device__ __forceinline__ unsigned xb_xcc_id() { return (unsigned)__builtin_amdgcn_s_getreg((3 << 11) | 20) & 0xFu; }
#define XB_SPIN(cond, bar) do { unsigned _sp = 0; while (cond) { __builtin_amdgcn_s_sleep(1); \
    if ((++_sp & 255u) == 0u) { if (xb_ld(&(bar)[XB_TMO])) break; if (_sp > XB_SPIN_CAP) { atomicAdd(&(bar)[XB_TMO], 1u); break; } } } } while (0)

struct XcdBarrier {
    unsigned* bar; unsigned x;
    volatile LAS unsigned* st;
};

__device__ __forceinline__ XcdBarrier xcd_barrier_post(unsigned* bar, volatile LAS unsigned* st) {
    XcdBarrier b; b.bar = bar; b.x = xb_xcc_id(); b.st = st;
    if (threadIdx.x == 0) (void)xb_add(&bar[XB_XCNT(b.x)], 1u);
    return b;
}
__device__ __forceinline__ void xcd_barrier_complete(unsigned* bar, unsigned x, unsigned& nloc, unsigned& nx) {
    const unsigned G = gridDim.x * gridDim.y * gridDim.z;
    unsigned sum, cnt, mine, sp = 0u;
    for (;;) {
        sum = 0u; cnt = 0u; mine = 0u;
#pragma unroll
        for (unsigned j = 0; j < 16; ++j) { const unsigned c = xb_ld(&bar[XB_XCNT(j)]); sum += c; cnt += (c > 0u) ? 1u : 0u; mine = (j == x) ? c : mine; }
        if (sum == G) break;
        __builtin_amdgcn_s_sleep(1);
        if ((++sp & 255u) == 0u) { if (xb_ld(&bar[XB_TMO])) break; if (sp > XB_SPIN_CAP) { atomicAdd(&bar[XB_TMO], 1u); break; } }
    }
    nloc = mine > 0u ? mine : 1u; nx = cnt > 0u ? cnt : 1u;
}

__device__ __forceinline__ void xcd_barrier(const XcdBarrier& b) {
    asm volatile("s_waitcnt vmcnt(0)" ::: "memory");
    __syncthreads();
    if (threadIdx.x == 0) {
        unsigned* bar = b.bar;
        __builtin_amdgcn_s_waitcnt(0);

        unsigned nloc = b.st[0], nx = b.st[1];
        if (nloc == 0u) { xcd_barrier_complete(bar, b.x, nloc, nx); b.st[0] = nloc; b.st[1] = nx; }
        const unsigned old = xb_add(&bar[XB_XSUB(b.x)], 1u);
        const unsigned gen = old / nloc;
        if (old + 1u == (gen + 1u) * nloc) {
            __builtin_amdgcn_fence(__ATOMIC_RELEASE, "agent");
            asm volatile("s_waitcnt vmcnt(0)" ::: "memory");
            const unsigned og = xb_add(&bar[XB_TOP], 1u);
            const unsigned tg = og / nx;
            if (og + 1u == (tg + 1u) * nx) xb_add(&bar[XB_TOPGEN], 1u);
            else XB_SPIN(xb_ld(&bar[XB_TOPGEN]) == tg, bar);
            __builtin_amdgcn_fence(__ATOMIC_ACQUIRE, "agent");
            xb_add(&bar[XB_XGEN(b.x)], 1u);
            asm volatile("s_waitcnt vmcnt(0)" ::: "memory");
        } else {
            XB_SPIN(xb_ld(&bar[XB_XGEN(b.x)]) == gen, bar);
            __builtin_amdgcn_fence(__ATOMIC_ACQUIRE, "agent");
            asm volatile("s_waitcnt vmcnt(0)" ::: "memory");
        }
    }
    __syncthreads();
}


struct CmpOrder {
    int G, c, lda, ldb;
    __device__ bool next(int i, pg8::Unit& u) const { const int L = i * G + c; if (L >= 64) return false; u.pm = L; u.pn = 0; u.aoff = (long)L * 256 * lda; u.boff = (long)(L >> 5) * 256 * ldb; return true; }
};
struct CmpOrderA {
    int G, c;
    __device__ bool next(int i, pg8::Unit& u) const {
        const int L = i * G + c; if (L >= 64) return false;
        const int kv = L >> 5, r = L & 31, bg = r >> 1, half = r & 1, b = bg >> 1, g = bg & 1;
        u.pm = L; u.pn = 0; u.aoff = (long)(b * SEQ + 16 * 256 * half) * PQ_LD + 512 + kv * 128 + g * 64; u.boff = (long)kv * 256 * 2048; return true;
    }
};
struct MemOrder {
    int c, c0, mode;
    __device__ bool next(int i, pg8::Unit& u) const {
        if (i > 0 || c < c0 || c >= c0 + 32) return false; const int L = c - c0;
        if (mode == 0) { u.pm = L >> 2; u.pn = L & 3; } else { u.pm = L >> 3; u.pn = L & 7; }
        u.aoff = (long)u.pm * 256 * 1024; u.boff = (long)u.pn * 256 * 1024; return true;
    }
};
struct XOrder {
    int G, c, mode;
    __device__ bool next(int i, pg8::Unit& u) const {
        const int L = i * G + c; if (L >= 1024) return false;
        const int h = L & 3, pm = L >> 2, b = pm >> 5;
        u.pm = pm; u.pn = h; u.aoff = (long)pm * 256 * 1024 + h * 256;
        u.boff = mode == 0 ? (long)(b * 256) * 1024 + h * 256 : (long)(h * 256) * 2048 + b * 256;
        if (mode == 2) { u.aoff = (long)pm * 256 * 1024; u.boff = (long)h * 256 * 1024; }
        return true;
    }
};

__global__ void __launch_bounds__(512, 2) fwd_megakernel(Params p) {
    extern __shared__ __attribute__((aligned(16))) unsigned char lds[];
    cg::grid_group grid = cg::this_grid();
    PG8_LAS unsigned char* lds3 = (PG8_LAS unsigned char*)lds;
    const int wave = __builtin_amdgcn_readfirstlane(threadIdx.x >> 6), G = gridDim.x, bid = blockIdx.x;
    const int gw = bid * 8 + wave, NGW = G * 8;
#define GSYNC() xcd_barrier(xbar)
#define LOCAL_TID int tid = threadIdx.x; asm volatile("" : "+v"(tid)); const int lane = tid & 63; (void)lane;
    unsigned char* ws = p.ws; unsigned char* dob = (unsigned char*)p.out;
    float* CBP = (float*)(ws + WS_CB); float* CB = CBP + 2 * 64 * 256;
    float* Lacc = (float*)(ws + WS_LP); float* SS = (float*)(ws + WS_SS);
    bf16_t* W1GU = (bf16_t*)(ws + WS_W1GU); bf16_t* W1D = (bf16_t*)(ws + WS_W1D); bf16_t* W2GU = (bf16_t*)(ws + WS_W2GU); bf16_t* W2D = (bf16_t*)(ws + WS_W2D);
    bf16_t* WIN = (bf16_t*)(ws + WS_WIN); bf16_t* WC1 = (bf16_t*)(ws + WS_WC1); bf16_t* WC2 = (bf16_t*)(ws + WS_WC2);
    bf16_t* WUA = (bf16_t*)(ws + WS_WUA); bf16_t* WUB = (bf16_t*)(ws + WS_WUB); bf16_t* WOUT = (bf16_t*)(ws + WS_WOUT);
    bf16_t* WXQ = (bf16_t*)(ws + WS_WXQ); bf16_t* WXKV = (bf16_t*)(ws + WS_WXKV); bf16_t* WXO = (bf16_t*)(ws + WS_WXO);
    bf16_t* XN = (bf16_t*)(ws + WS_XN); bf16_t* OA = (bf16_t*)(ws + WS_OA); bf16_t* OB = OA + 512;
    bf16_t* Hb = (bf16_t*)(ws + WS_H); bf16_t* PQ = (bf16_t*)(ws + WS_PQ); bf16_t* PG = (bf16_t*)(ws + WS_PG); bf16_t* MERGED = (bf16_t*)(ws + WS_MERGED);
    bf16_t* QX = (bf16_t*)(ws + WS_QX); bf16_t* PX = (bf16_t*)(ws + WS_PX); bf16_t* OX = (bf16_t*)(ws + WS_OX);
    bf16_t* MEMN = (bf16_t*)(ws + WS_MEMN); bf16_t* KM = (bf16_t*)(ws + WS_KM); bf16_t* VMT = (bf16_t*)(ws + WS_VMT);
    bf16_t* ACMP = (bf16_t*)(dob + DO_ACMP); bf16_t* HC = (bf16_t*)(dob + DO_HC); bf16_t* KC = (bf16_t*)(dob + DO_KC); bf16_t* VCT = (bf16_t*)(dob + DO_VCT);
    bf16_t* KVS = (bf16_t*)(dob + DO_KVS); bf16_t* KVW = (bf16_t*)(dob + DO_KVW); bf16_t* KVB = (bf16_t*)(dob + DO_KVB); float* Tb = (float*)(dob + DO_T);

    {
        LOCAL_TID
        float* scr = (float*)(lds + wave * 16384);
#define CONVX(idx, K_, N_, dst, ldd, kofs, kind, roff, gptr) for (int it = gw; it < ((K_) / 64) * (((N_) + 31) / 32); it += NGW) conv_item(p.in[idx], K_, N_, dst, ldd, kofs, kind, roff, gptr, scr, it, lane)
#define CONVG(idx, K_, N_, dst, kind, roff, gptr) CONVX(idx, K_, N_, dst, K_, 0, kind, roff, gptr)
#define CONV(idx, K_, N_, dst, kind, roff) CONVG(idx, K_, N_, dst, kind, roff, nullptr)
        CONV(3, 1024, 2816, W1GU, 1, 0); CONV(4, 1024, 2816, W1GU, 2, 0); CONV(5, 2816, 1024, W1D, 0, 0);
        CONVG(25, 1024, 2816, W2GU, 1, 0, p.in[24]); CONVG(26, 1024, 2816, W2GU, 2, 0, p.in[24]); CONV(27, 2816, 1024, W2D, 0, 0);
        CONVG(7, 1024, 4120, WIN, 3, 0, p.in[6]);
        CONV(9, 2048, 256, WC1, 0, 0); CONV(12, 2048, 256, WC1, 0, 256);
        CONV(10, 256, 64, WC2, 0, 0); CONV(13, 256, 64, WC2, 0, 256);
        CONVX(16, 512, 1024, WUA, 1024, 0, 0, 0, nullptr); CONVX(17, 512, 1024, WUA, 1024, 512, 0, 0, nullptr);   CONV(18, 1024, 1024, WOUT, 0, 0);
        CONVG(21, 1024, 1024, WXQ, 4, 0, p.in[19]); CONV(22, 1024, 2048, WXKV, 0, 0); CONV(23, 1024, 1024, WXO, 0, 0);
#undef CONV
#undef CONVG
#undef CONVX
        const int gt = bid * 512 + tid, GT = G * 512;
        for (int i = gt; i < 232 * 1024 / 8; i += GT) *((u32x4*)(WIN + (size_t)2072 * 1024) + i) = (u32x4){0u, 0u, 0u, 0u};
        for (int i = gt; i < 192 * 256 / 8; i += GT) { *((u32x4*)(WC2 + 64 * 256) + i) = (u32x4){0u, 0u, 0u, 0u}; *((u32x4*)(WC2 + 320 * 256) + i) = (u32x4){0u, 0u, 0u, 0u}; }
        rms_pass(p.in[0], p.in[2], XN, nullptr, M, gw, NGW);
        rms_pass(p.in[1], p.in[20], MEMN, nullptr, 2048, gw, NGW);
        for (int t = gw; t < 512; t += NGW) {
            const int kv = t >> 8, kc = (t >> 2) & 63, c = (t & 3) * 64 + lane; const float* pe = p.in[kv ? 11 : 8] + kc * 32; const float* w1 = p.in[kv ? 12 : 9] + (size_t)kc * 32 * 256 + c;
            float a0 = 0.f, a1 = 0.f, a2 = 0.f, a3 = 0.f;
            for (int k = 0; k < 32; k += 4) { a0 += pe[k] * w1[(size_t)k * 256]; a1 += pe[k + 1] * w1[(size_t)(k + 1) * 256]; a2 += pe[k + 2] * w1[(size_t)(k + 2) * 256]; a3 += pe[k + 3] * w1[(size_t)(k + 3) * 256]; }
            CBP[(kv * 64 + kc) * 256 + c] = (a0 + a1) + (a2 + a3);
        }
        if (bid == 0) for (int i = tid; i < (int)(BAR_BYTES / 4); i += 512) ((unsigned*)p.ws)[i] = 0u;
    }
    grid.sync();
    { volatile LAS unsigned* st = (volatile LAS unsigned*)(lds3 + BAR_LDS_OFF); if (threadIdx.x < 2) st[threadIdx.x] = 0u; __syncthreads(); }
    const XcdBarrier xbar = xcd_barrier_post((unsigned*)p.ws, (volatile LAS unsigned*)(lds3 + BAR_LDS_OFF));
    { const int gt = bid * 512 + (int)threadIdx.x; if (gt < 512) { float t0 = 0.f, t1 = 0.f, t2 = 0.f, t3 = 0.f; for (int kc = 0; kc < 64; kc += 4) { const float* q_ = CBP + ((gt >> 8) * 64 + kc) * 256 + (gt & 255); t0 += q_[0]; t1 += q_[256]; t2 += q_[512]; t3 += q_[768]; } CB[gt] = (t0 + t1) + (t2 + t3); } }
    { pg8::Gemm g{XN, W1GU, 1024, 1024, 1024}; pg8::StaticOrder S; S.init(M, 5632, 1024, 1024, G, bid); pg8::EpiSwiglu E{Hb, DFF, nullptr}; pg8::gemm_phase(lds3, g, S, E); }
    GSYNC();
    { pg8::Gemm g{Hb, W1D, DFF, DFF, DFF}; pg8::StaticOrder S; S.init(M, 1024, DFF, DFF, G, bid); pg8::EpiResid E{p.in[0], XN, SS, 0.5f}; pg8::gemm_phase(lds3, g, S, E); }
    GSYNC();
    { pg8::Gemm g{XN, WIN, 1024, 1024, 1024}; pg8::StaticOrder S; S.init(M, 4352, 1024, 1024, G, bid); pg8::EpiBf16 E{PQ, PQ_LD, 9, PG, PG_LD, 0, 1, nullptr, SS, nullptr}; pg8::gemm_phase(lds3, g, S, E); }
    GSYNC();
    { pg8::Gemm g{PQ, WC1, 16 * PQ_LD, 2048, 2048, PQ_LD * 2}; CmpOrderA S{G, bid}; pg8::EpiBf16 E{HC, 256, 1 << 30, nullptr, 0, 2, 0, nullptr, nullptr, CB}; pg8::gemm_phase(lds3, g, S, E); }
    { pg8::Gemm g{MEMN, WXKV, 1024, 1024, 1024}; MemOrder S{bid, G >= 128 ? 64 : 0, 0}; pg8::EpiBf16 E{KM, 1024, 1 << 30, nullptr, 0, 0, 0, nullptr, nullptr, nullptr}; pg8::gemm_phase(lds3, g, S, E); }
    if (G < 128 || bid >= 64) {
        LOCAL_TID
        const int cb0 = G < 128 ? bid : bid - 64, cG = G < 128 ? G : G - 64;
        bf16_t* tile = (bf16_t*)lds;
        for (int it0 = cb0; it0 < 3 * 16 * 128; it0 += 2 * cG) {
            const int row = tid >> 3, ch = tid & 7;
            const bool two = (it0 + cG) < 3 * 16 * 128;
            u32x4 kx[2], vx[2]; bf16_t* blk[2];
#pragma unroll
            for (int z = 0; z < 2; ++z) {
                const int it = (z == 0 || two) ? it0 + z * cG : it0;
                const int tb = it & 127, bg = (it >> 7) & 15, x = it >> 11, b = bg >> 1, g = bg & 1;
                const int kcol = (x == 0 ? 768 : (x == 1 ? 1024 : 1816)) + g * 64, vcol = (x == 0 ? 896 : (x == 1 ? 1152 : 1944)) + g * 64;
                blk[z] = (x == 0 ? KVS : (x == 1 ? KVW : KVB)) + (size_t)(bg * 128 + tb) * 8192;
                const bf16_t* src = PQ + (size_t)(b * SEQ + tb * 64 + row) * PQ_LD;
                kx[z] = *(const u32x4*)(src + kcol + ch * 8); vx[z] = *(const u32x4*)(src + vcol + ch * 8);
            }
            __syncthreads();
#pragma unroll
            for (int z = 0; z < 2; ++z) { if (z == 0 || two) *(u32x4*)(blk[z] + row * 64 + ch * 8) = kx[z]; *(u32x4*)(tile + z * 64 * 72 + row * 72 + ch * 8) = vx[z]; }
            __syncthreads();
#pragma unroll
            for (int z = 0; z < 2; ++z) {
                unsigned short e[8];
#pragma unroll
                for (int k = 0; k < 8; ++k) e[k] = tile[z * 64 * 72 + (ch * 8 + k) * 72 + row];
                u32x4 o; o.x = e[0] | ((unsigned)e[1] << 16); o.y = e[2] | ((unsigned)e[3] << 16); o.z = e[4] | ((unsigned)e[5] << 16); o.w = e[6] | ((unsigned)e[7] << 16);
                if (z == 0 || two) *(u32x4*)(blk[z] + 4096 + row * 64 + ch * 8) = o;
            }
        }
        __syncthreads();
    }
    { pg8::Gemm g{WXKV + (size_t)1024 * 1024, MEMN, 1024, 1024, 1024}; MemOrder S{bid, G >= 128 ? 96 : 0, 1}; pg8::EpiBf16 E{VMT, 2048, 1 << 30, nullptr, 0, 0, 0, nullptr, nullptr, nullptr}; pg8::gemm_phase(lds3, g, S, E); }
    { pg8::Gemm g{HC, WC2, 256, 256, 256}; CmpOrder S{G, bid, 256, 256}; pg8::EpiCmp2 E{KC, VCT}; pg8::gemm_phase(lds3, g, S, E); }
    GSYNC();
    {
        LOCAL_TID
        float* btab = (float*)(lds + att::OFF_BT);
        __syncthreads();
        for (int i = tid; i < 129 * 16; i += 512) { const int d = i >> 4, hh = i & 15; const int bk = d < 128 ? t5_bucket(d) : 31; btab[i] = p.in[15][bk * 16 + hh] * LOG2E; }
        __syncthreads();
        att::Args a{PQ, KC, VCT, KVS, KVW, KVB, OA, OB, p.in[14]};
        const bool xo = (G == 256); const int nun = xo ? 8 : (2048 - bid + G - 1) / G;
        for (int i = 0; i < 2 * nun; ++i) {
            const int iu = i < nun ? i : i - nun; int bg, T;
            if (xo) { const int x = bid & 7, wi = bid >> 3, ii = iu & 3; bg = (iu < 4) ? x : x + 8; T = ii == 0 ? wi : (ii == 1 ? 63 - wi : (ii == 2 ? 64 + wi : 127 - wi)); }
            else { const int idx = bid + iu * G, tt = idx >> 4, i2 = tt >> 4, k = tt & 15; bg = idx & 15; T = (i2 & 1) ? (16 * i2 + 15 - k) : (16 * i2 + k); }
            if (i < nun) att::unitA(lds, lds3, a, bg >> 1, bg & 1, T); else att::unitB(lds, lds3, a, bg >> 1, bg & 1, T);
        }
        __syncthreads();
    }
    GSYNC();
    { pg8::Gemm g{OA, WUA, 1024, 1024, 1024}; pg8::StaticOrder S; S.init(M, 1024, 1024, 1024, G, bid); pg8::EpiGate E{PG, PG_LD, MERGED}; pg8::gemm_phase(lds3, g, S, E); }
    GSYNC();
    { pg8::Gemm g{MERGED, WOUT, 1024, 1024, 1024}; pg8::StaticOrder S; S.init(M, 1024, 1024, 1024, G, bid); pg8::EpiResid E{nullptr, XN, SS + (size_t)16 * M, 1.0f}; pg8::gemm_phase(lds3, g, S, E); }
    GSYNC();
    { pg8::Gemm g{XN, WXQ, 1024, 1024, 1024}; XOrder S{G, bid, 2}; pg8::EpiBf16 E{QX, 1024, 1 << 30, nullptr, 0, 0, 0, nullptr, SS + (size_t)16 * M, nullptr}; pg8::gemm_phase(lds3, g, S, E); }
    { pg8::Gemm g{QX, KM, 1024, 1024, 256}; XOrder S{G, bid, 0}; pg8::EpiXS E{PX, Lacc}; pg8::gemm_phase(lds3, g, S, E); }
    { pg8::Gemm g{PX, VMT, 1024, 2048, 256}; XOrder S{G, bid, 1}; pg8::EpiBf16 E{OX, 1024, 1 << 30, nullptr, 0, 0, 0, Lacc, nullptr, nullptr}; pg8::gemm_phase(lds3, g, S, E); }
    GSYNC();
    { pg8::Gemm g{OX, WXO, 1024, 1024, 1024}; pg8::StaticOrder S; S.init(M, 1024, 1024, 1024, G, bid); pg8::EpiResid E{nullptr, XN, SS + (size_t)32 * M, 1.0f}; pg8::gemm_phase(lds3, g, S, E); }
    GSYNC();
    { pg8::Gemm g{XN, W2GU, 1024, 1024, 1024}; pg8::StaticOrder S; S.init(M, 5632, 1024, 1024, G, bid); pg8::EpiSwiglu E{Hb, DFF, SS + (size_t)32 * M}; pg8::gemm_phase(lds3, g, S, E); }
    GSYNC();
    { pg8::Gemm g{Hb, W2D, DFF, DFF, DFF}; pg8::StaticOrder S; S.init(M, 1024, DFF, DFF, G, bid); pg8::EpiResid E{nullptr, XN, nullptr, 0.5f}; pg8::gemm_phase(lds3, g, S, E); }
    GSYNC();
    rms_final(XN, p.in[28], p.out, M, gw, NGW);
}

extern "C" void kernel_launch(void* const* d_in, const int* in_sizes, int n_in, void* d_out, int out_size, void* d_ws, size_t ws_size, hipStream_t stream) {
    static int grid = 0; constexpr int LDS_BYTES = 147456;
    if (grid == 0) {
        if (n_in != 29 || out_size != M * DM || ws_size < WS_END) { fprintf(stderr, "kernel_launch: unexpected shapes (n_in %d out %d ws %zu)\n", n_in, out_size, ws_size); grid = -1; return; }
        int dev = 0, cus = 0, per_cu = 0;
        (void)hipGetDevice(&dev); (void)hipDeviceGetAttribute(&cus, hipDeviceAttributeMultiprocessorCount, dev);
        (void)hipFuncSetAttribute((const void*)fwd_megakernel, hipFuncAttributeMaxDynamicSharedMemorySize, LDS_BYTES);
        (void)hipOccupancyMaxActiveBlocksPerMultiprocessor(&per_cu, (const void*)fwd_megakernel, 512, LDS_BYTES);
        if (per_cu < 1) fprintf(stderr, "kernel_launch: occupancy query says %d blocks per CU\n", per_cu);
        (void)hipGetLastError();
        grid = cus > 0 ? cus : 256;
    }
    if (grid < 0) return;
    Params p{};
    for (int i = 0; i < 29; ++i) p.in[i] = (const float*)d_in[i];
    p.out = (float*)d_out; p.ws = (unsigned char*)d_ws;
    void* args[] = {&p};
    hipError_t e = hipLaunchCooperativeKernel((const void*)fwd_megakernel, dim3(grid), dim3(512), args, LDS_BYTES, stream);
    if (e != hipSuccess) fprintf(stderr, "cooperative launch failed: %s (grid %d)\n", hipGetErrorString(e), grid);
}
```
